# Optimizing an MI355X kernel written in HIP

```python
import math
import jax, jax.numpy as jnp
from jax import lax
import numpy as np

D_MODEL = 1024
BATCH = 8
SEQ = 2048
DEPTH = 2
DEC_BATCH = 128
DEC_SEQ = 8
PAST_LEN = 16384
PAGE_SIZE = 128

N_BRANCH = 4
CHUNK = 64
NORM_EPS = 1e-6
MIN_FORGET = 1e-30
HG_H = 4
HG_DK = 64
HG_DV = 64
HG_W = HG_H * HG_DV
GLA_H = 4
GLA_DK = 32
GLA_DV = 64
GLA_RANK = 16
GLA_TAU = 16.0
GLA_W = GLA_H * GLA_DV
RW_H = 4
RW_N = 64
RW_W = RW_H * RW_N
RW_DECAY_RANK = 64
RW_A_RANK = 64
RW_G_RANK = 128
RW_COLS = 3 * RW_W + RW_DECAY_RANK + RW_A_RANK + RW_G_RANK
RW_LN_EPS = 64e-5
RET_H = 4
RET_DK = 64
RET_DV = 64
RET_W = RET_H * RET_DV
ROPE_BASE = 10000.0
BRANCH_W = HG_W
D_FF = 256 * (-(-(8 * D_MODEL) // (3 * 256)))

IN_WIDTHS = (HG_H * HG_DK, HG_H * HG_DK, HG_W, HG_W,
             GLA_H * GLA_DK, GLA_H * GLA_DK, GLA_W, GLA_RANK, GLA_W,
             RW_COLS,
             RET_H * RET_DK, RET_H * RET_DK, RET_W, RET_W,
             N_BRANCH * D_MODEL)
N_IN = sum(IN_WIDTHS)
RW_WIDTHS = (RW_W, RW_DECAY_RANK, RW_W, RW_W, RW_A_RANK, RW_G_RANK)

kernel_name = 'hybrid_hgrn2_gla_rwkv7_retnet_step'


def _split(t, widths):
    return jnp.split(t, [int(i) for i in np.cumsum(widths)[:-1]], axis=-1)


def _heads(t, n):
    return t.reshape(t.shape[:-1] + (n, t.shape[-1] // n))


def _rmsnorm(x, w):
    xf = x.astype(jnp.float32)
    y = xf * lax.rsqrt(jnp.mean(xf * xf, axis=-1, keepdims=True) + NORM_EPS)
    return (y * w.astype(jnp.float32)).astype(x.dtype)


def _head_rms(o):
    return o * lax.rsqrt(jnp.mean(o * o, axis=-1, keepdims=True) + NORM_EPS)


def _head_layernorm(o, w, b):
    mu = jnp.mean(o, axis=-1, keepdims=True)
    var = jnp.mean(jnp.square(o - mu), axis=-1, keepdims=True)
    return (o - mu) * lax.rsqrt(var + RW_LN_EPS) * w.reshape(o.shape[-2:]) + b.reshape(o.shape[-2:])


def _rotary(x, pos):
    half = x.shape[-1] // 2
    inv = ROPE_BASE ** (-jnp.arange(half, dtype=jnp.float32) / half)
    ang = pos[:, None] * inv[None, :]
    cos = jnp.cos(ang)[None, :, None, :]
    sin = jnp.sin(ang)[None, :, None, :]
    x1, x2 = x[..., :half], x[..., half:]
    return jnp.concatenate([x1 * cos - x2 * sin, x1 * sin + x2 * cos], axis=-1)


def gated_linear_attention_chunked(q, k, v, log_g, s0):
    B, L, H, _ = q.shape
    dv = v.shape[-1]
    C = math.gcd(L, CHUNK)
    n = L // C

    def to_chunks(t):
        return t.reshape(B, n, C, H, t.shape[-1]).transpose(1, 0, 3, 2, 4)

    causal = jnp.tril(jnp.ones((C, C), dtype=jnp.float32))[None, None, :, :, None]

    def step(S, inp):
        qb, kb, vb, gb = inp
        b = jnp.cumsum(gb, axis=2)
        diff = b[:, :, :, None, :] - b[:, :, None, :, :]
        decay = jnp.exp(jnp.where(causal > 0, diff, 0.0)) * causal
        scores = jnp.sum(qb[:, :, :, None, :] * kb[:, :, None, :, :] * decay, axis=-1)
        o = (jnp.einsum('bhts,bhsv->bhtv', scores, vb)
             + jnp.einsum('bhtk,bhkv->bhtv', qb * jnp.exp(b), S))
        b_last = b[:, :, -1:, :]
        S_new = (jnp.exp(b_last[:, :, 0, :])[..., None] * S
                 + jnp.einsum('bhsk,bhsv->bhkv', kb * jnp.exp(b_last - b), vb))
        return S_new, o

    S, o = lax.scan(step, s0.astype(jnp.float32),
                    (to_chunks(q), to_chunks(k), to_chunks(v), to_chunks(log_g)))
    o = o.transpose(1, 0, 3, 2, 4).reshape(B, L, H, dv)
    return o, S


def rwkv7_recurrence(r, log_w, k, v, kk, a, s0):
    def step(S, inp):
        r_t, lw_t, k_t, v_t, kk_t, a_t = inp
        kS = jnp.einsum('bhk,bhkv->bhv', kk_t, S)
        S = (jnp.exp(lw_t)[..., None] * S
             - (a_t * kk_t)[..., None] * kS[..., None, :]
             + k_t[..., None] * v_t[..., None, :])
        return S, jnp.einsum('bhk,bhkv->bhv', r_t, S)

    xs = (r.transpose(1, 0, 2, 3), log_w.transpose(1, 0, 2, 3), k.transpose(1, 0, 2, 3),
          v.transpose(1, 0, 2, 3), kk.transpose(1, 0, 2, 3), a.transpose(1, 0, 2, 3))
    S, o = lax.scan(step, s0.astype(jnp.float32), xs)
    return o.transpose(1, 0, 2, 3), S


def token_mixing(h, pos, states, lw):
    f32 = jnp.float32
    B, L, _ = h.shape
    s_hg, s_gla, s_rw, s_shift, s_ret = states
    proj = (h @ lw['w_in']).astype(f32)
    (hg_q, hg_f, hg_i, hg_g, gla_q, gla_k, gla_v, gla_a, gla_g, rw_cols,
     ret_q, ret_k, ret_v, ret_g, gate_logits) = _split(proj, IN_WIDTHS)

    lb = lw['hg_lb']
    forget = lb + (1.0 - lb) * jax.nn.sigmoid(hg_f)
    log_f = jnp.log(jnp.maximum(forget, MIN_FORGET))
    o_hg, n_hg = gated_linear_attention_chunked(
        _heads(jax.nn.silu(hg_q), HG_H), _heads(1.0 - forget, HG_H),
        _heads(hg_i, HG_H), _heads(log_f, HG_H), s_hg)
    o_hg = (_head_rms(o_hg) * lw['hg_norm_w']).reshape(B, L, HG_W) * jax.nn.silu(hg_g)

    log_a = jax.nn.log_sigmoid(gla_a @ lw['gla_wa2'] + lw['gla_ba']) / GLA_TAU
    o_gla, n_gla = gated_linear_attention_chunked(
        _heads(gla_q * GLA_DK ** -0.5, GLA_H), _heads(gla_k, GLA_H),
        _heads(gla_v, GLA_H), _heads(log_a, GLA_H), s_gla)
    o_gla = (_head_rms(o_gla) * lw['gla_norm_w']).reshape(B, L, GLA_W) * jax.nn.silu(gla_g)

    prev = jnp.concatenate([s_shift.astype(f32)[:, None, :], rw_cols[:, :-1]], axis=1)
    rw_mix = rw_cols + (prev - rw_cols) * lw['rw_mu']
    r, w_d, k, v, a_d, g_d = _split(rw_mix, RW_WIDTHS)
    log_w = -math.exp(-0.5) * jax.nn.sigmoid(lw['rw_w0'] + jnp.tanh(w_d) @ lw['rw_w2'])
    a = jax.nn.sigmoid(lw['rw_a0'] + a_d @ lw['rw_a2'])
    g = jax.nn.sigmoid(g_d) @ lw['rw_g2']
    kk = _heads(k * lw['rw_kk'], RW_H)
    kk = kk / jnp.maximum(jnp.sqrt(jnp.sum(kk * kk, axis=-1, keepdims=True)), 1e-12)
    k = k * (1.0 + (a - 1.0) * lw['rw_ka'])
    r_h, k_h, v_h = _heads(r, RW_H), _heads(k, RW_H), _heads(v, RW_H)
    o_rw, n_rw = rwkv7_recurrence(r_h, _heads(log_w, RW_H), k_h, v_h, kk, _heads(a, RW_H), s_rw)
    bonus = jnp.sum(r_h * k_h * lw['rw_rk'].reshape(RW_H, RW_N), axis=-1, keepdims=True) * v_h
    o_rw = (_head_layernorm(o_rw, lw['rw_ln_w'], lw['rw_ln_b']) + bonus).reshape(B, L, RW_W) * g

    q_r = _rotary(_heads(ret_q, RET_H), pos)
    k_r = _rotary(_heads(ret_k, RET_H), pos) * RET_DK ** -0.5
    log_gamma = jnp.log1p(-jnp.exp2(-5.0 - jnp.arange(RET_H, dtype=f32)))
    log_gamma = jnp.broadcast_to(log_gamma[:, None], (B, L, RET_H, 1))
    o_ret, n_ret = gated_linear_attention_chunked(q_r, k_r, _heads(ret_v, RET_H), log_gamma, s_ret)
    o_ret = _head_rms(o_ret).reshape(B, L, RET_W) * jax.nn.silu(ret_g)

    branches = jnp.stack([o_hg, o_gla, o_rw, o_ret], axis=2).astype(h.dtype)
    up = jnp.einsum('blnc,ncd->blnd', branches, lw['w_branch'])
    gates = jax.nn.sigmoid(gate_logits.reshape(B, L, N_BRANCH, D_MODEL))
    merged = jnp.sum(gates * up, axis=2).astype(h.dtype)
    y = merged @ lw['w_out']
    dt = h.dtype
    new_states = (n_hg.astype(dt), n_gla.astype(dt), n_rw.astype(dt),
                  rw_cols[:, -1].astype(dt), n_ret.astype(dt))
    return y, new_states


def decoder_layer(x, pos, states, lw):
    y, new_states = token_mixing(_rmsnorm(x, lw['attn_norm']), pos, states, lw)
    x = x + y.astype(x.dtype)
    h = _rmsnorm(x, lw['ffn_norm'])
    g, u = jnp.split(h @ lw['w_ffn_in'], 2, axis=-1)
    x = x + ((jax.nn.silu(g) * u) @ lw['w_ffn_out']).astype(x.dtype)
    return x, new_states


def setup_inputs(seed: int = 0) -> dict:
    key = jax.random.key(seed)
    keys = iter(jax.random.split(key, 40))

    def nrm(shape, scale):
        return scale * jax.random.normal(next(keys), shape, jnp.float32)

    return {
        'x_prompt': nrm((BATCH, SEQ, D_MODEL), 1.0),
        'x_sample': nrm((DEC_BATCH, DEC_SEQ, D_MODEL), 1.0),
        'state_hgrn': nrm((DEPTH, DEC_BATCH, HG_H, HG_DK, HG_DV), 0.5),
        'state_gla': nrm((DEPTH, DEC_BATCH, GLA_H, GLA_DK, GLA_DV), 0.5),
        'state_rwkv': nrm((DEPTH, DEC_BATCH, RW_H, RW_N, RW_N), 0.5),
        'state_rwkv_shift': nrm((DEPTH, DEC_BATCH, RW_COLS), 1.0),
        'state_ret': nrm((DEPTH, DEC_BATCH, RET_H, RET_DK, RET_DV), 0.5),
        'attn_norm_w': 1.0 + nrm((DEPTH, D_MODEL), 0.1),
        'w_in': nrm((DEPTH, D_MODEL, N_IN), D_MODEL ** -0.5),
        'hg_lb_logits': nrm((DEPTH, HG_H * HG_DK), 0.5),
        'hg_norm_w': 1.0 + nrm((DEPTH, HG_DV), 0.1),
        'gla_wa2': nrm((DEPTH, GLA_RANK, GLA_H * GLA_DK), GLA_RANK ** -0.5),
        'gla_ba': nrm((DEPTH, GLA_H * GLA_DK), 0.1),
        'gla_norm_w': 1.0 + nrm((DEPTH, GLA_DV), 0.1),
        'rw_mu': jax.random.uniform(next(keys), (DEPTH, RW_COLS), jnp.float32),
        'rw_w0': nrm((DEPTH, RW_W), 0.5),
        'rw_w2': nrm((DEPTH, RW_DECAY_RANK, RW_W), 0.1 * RW_DECAY_RANK ** -0.5),
        'rw_a0': nrm((DEPTH, RW_W), 0.1),
        'rw_a2': nrm((DEPTH, RW_A_RANK, RW_W), 0.1 * RW_A_RANK ** -0.5),
        'rw_g2': nrm((DEPTH, RW_G_RANK, RW_W), RW_G_RANK ** -0.5),
        'rw_kk': 0.85 + nrm((DEPTH, RW_W), 0.1),
        'rw_ka': 1.0 + nrm((DEPTH, RW_W), 0.1),
        'rw_rk': nrm((DEPTH, RW_W), 0.1),
        'rw_ln_w': 1.0 + nrm((DEPTH, RW_W), 0.1),
        'rw_ln_b': nrm((DEPTH, RW_W), 0.01),
        'w_branch': nrm((DEPTH, N_BRANCH, BRANCH_W, D_MODEL), BRANCH_W ** -0.5),
        'w_out': nrm((DEPTH, D_MODEL, D_MODEL), D_MODEL ** -0.5),
        'ffn_norm_w': 1.0 + nrm((DEPTH, D_MODEL), 0.1),
        'w_ffn_in': nrm((DEPTH, D_MODEL, 2 * D_FF), D_MODEL ** -0.5),
        'w_ffn_out': nrm((DEPTH, D_FF, D_MODEL), D_FF ** -0.5),
        'final_norm_w': 1.0 + nrm((D_MODEL,), 0.1),
    }


def reference(x_prompt, x_sample, state_hgrn, state_gla, state_rwkv, state_rwkv_shift, state_ret,
              attn_norm_w, w_in, hg_lb_logits, hg_norm_w, gla_wa2, gla_ba, gla_norm_w,
              rw_mu, rw_w0, rw_w2, rw_a0, rw_a2, rw_g2, rw_kk, rw_ka, rw_rk, rw_ln_w, rw_ln_b,
              w_branch, w_out, ffn_norm_w, w_ffn_in, w_ffn_out, final_norm_w):
    f32 = jnp.float32
    lb_p = jax.nn.softmax(hg_lb_logits.astype(f32), axis=0)
    lower_bounds = jnp.cumsum(lb_p, axis=0) - lb_p[0:1]

    Bp, Lp, _ = x_prompt.shape
    Ls = x_sample.shape[1]
    pos_p = jnp.arange(Lp, dtype=f32)
    pos_s = float(PAST_LEN) + jnp.arange(Ls, dtype=f32)
    dt = x_prompt.dtype
    zero_states = (jnp.zeros((Bp, HG_H, HG_DK, HG_DV), dt),
                   jnp.zeros((Bp, GLA_H, GLA_DK, GLA_DV), dt),
                   jnp.zeros((Bp, RW_H, RW_N, RW_N), dt),
                   jnp.zeros((Bp, RW_COLS), dt),
                   jnp.zeros((Bp, RET_H, RET_DK, RET_DV), dt))

    xp, xs = x_prompt, x_sample
    p_states, s_states = [], []
    for l in range(DEPTH):
        lw = {
            'attn_norm': attn_norm_w[l], 'w_in': w_in[l],
            'hg_lb': lower_bounds[l], 'hg_norm_w': hg_norm_w[l],
            'gla_wa2': gla_wa2[l], 'gla_ba': gla_ba[l], 'gla_norm_w': gla_norm_w[l],
            'rw_mu': rw_mu[l], 'rw_w0': rw_w0[l], 'rw_w2': rw_w2[l], 'rw_a0': rw_a0[l],
            'rw_a2': rw_a2[l], 'rw_g2': rw_g2[l], 'rw_kk': rw_kk[l], 'rw_ka': rw_ka[l],
            'rw_rk': rw_rk[l], 'rw_ln_w': rw_ln_w[l], 'rw_ln_b': rw_ln_b[l],
            'w_branch': w_branch[l], 'w_out': w_out[l],
            'ffn_norm': ffn_norm_w[l], 'w_ffn_in': w_ffn_in[l], 'w_ffn_out': w_ffn_out[l],
        }
        xp, sp = decoder_layer(xp, pos_p, zero_states, lw)
        xs, ss = decoder_layer(xs, pos_s, (state_hgrn[l], state_gla[l], state_rwkv[l],
                                           state_rwkv_shift[l], state_ret[l]), lw)
        p_states.append(sp)
        s_states.append(ss)

    y_prompt = _rmsnorm(xp, final_norm_w)
    y_sample = _rmsnorm(xs, final_norm_w)
    prompt_hgrn = jnp.stack([s[0] for s in p_states])
    prompt_gla = jnp.stack([s[1] for s in p_states])
    prompt_rwkv = jnp.stack([s[2] for s in p_states])
    prompt_rwkv_shift = jnp.stack([s[3] for s in p_states])
    prompt_ret = jnp.stack([s[4] for s in p_states])
    sample_hgrn = jnp.stack([s[0] for s in s_states])
    sample_gla = jnp.stack([s[1] for s in s_states])
    sample_rwkv = jnp.stack([s[2] for s in s_states])
    sample_rwkv_shift = jnp.stack([s[3] for s in s_states])
    sample_ret = jnp.stack([s[4] for s in s_states])
    return (y_prompt, y_sample,
            prompt_hgrn, prompt_gla, prompt_rwkv, prompt_rwkv_shift, prompt_ret,
            sample_hgrn, sample_gla, sample_rwkv, sample_rwkv_shift, sample_ret)
```

```cpp
#include <hip/hip_runtime.h>
#include <hip/hip_cooperative_groups.h>
#include <cstdio>
namespace cg = cooperative_groups;

#ifndef MEGA
#define MEGA 0
#endif

typedef _Float16 h16;
typedef _Float16 h16x8 __attribute__((ext_vector_type(8)));
typedef _Float16 h16x4 __attribute__((ext_vector_type(4)));
typedef _Float16 h16x2 __attribute__((ext_vector_type(2)));
typedef float f32x4 __attribute__((ext_vector_type(4)));
#define DEV __device__ __forceinline__

constexpr int M_TOK = 17408, M_PROMPT = 16384, DM = 1024, NPC = 3856  , DFF = 2816;
constexpr int C_HGQ = 0, C_HGF = 256, C_HGI = 512, C_HGG = 768;
constexpr int C_GLQ = 1024, C_GLK = 1152, C_GLV = 1280, C_GLA = 1536, C_GLG = 1552;
constexpr int C_RW = 1808;
constexpr int C_RTQ = 2832, C_RTK = 3088, C_RTV = 3344, C_RTG = 3600;
constexpr size_t WT_IN = 0, WT_G = 4063232, WT_BR = 8257536, WT_OUT = 9306112, WT_FIN = 10354688, WT_FOUT = 16121856,
                 WT_TOTAL = 19005440;
constexpr size_t WS_WT = 0, WS_H = WS_WT + WT_TOTAL * 2, WS_O = WS_H + (size_t)M_TOK * DM * 2, WS_P = WS_O + (size_t)M_TOK * DM * 2,
                 WS_RWP = WS_P + (size_t)M_TOK * NPC * 2, WS_ROPE = WS_RWP + (size_t)M_TOK * 512 * 2,
                 WS_CTR = WS_ROPE + (size_t)2056 * 64 * 4, WS_END = WS_CTR + 256;
constexpr size_t O_PHG = 17825792, O_PGLA = 18087936, O_PRW = 18219008, O_PSH = 18481152, O_PRET = 18497536, O_SHG = 18759680,
                 O_SGLA = 22953984, O_SRW = 25051136, O_SSH = 29245440, O_SRET = 29507584;

struct Params {
  const float *x_prompt, *x_sample, *st_hg, *st_gla, *st_rw, *st_shift, *st_ret;
  const float *attn_norm_w, *w_in, *hg_lb_logits, *hg_norm_w, *gla_wa2, *gla_ba, *gla_norm_w;
  const float *rw_mu, *rw_w0, *rw_w2, *rw_a0, *rw_a2, *rw_g2, *rw_kk, *rw_ka, *rw_rk, *rw_ln_w, *rw_ln_b;
  const float *w_branch, *w_out, *ffn_norm_w, *w_ffn_in, *w_ffn_out, *final_norm_w;
  float* out;
  h16 *WT, *h, *o, *P, *RWp;
  float* rope;
  unsigned* ctr;
};

DEV float sigm(float x) { return 1.f / (1.f + __expf(-x)); }
DEV float silu(float x) { return x * sigm(x); }
template <int CTRL> DEV float dpp_f(float x) {
  return __int_as_float(__builtin_amdgcn_update_dpp(0, __float_as_int(x), CTRL, 0xf, 0xf, false));
}
DEV float row16_sum(float x) {
  x += dpp_f<0x128>(x); x += dpp_f<0x124>(x); x += dpp_f<0x122>(x); x += dpp_f<0x121>(x);
  return x;
}
DEV float wave_sum(float x) {
  x = row16_sum(x);
  x += __shfl_xor(x, 16);
  x += __shfl_xor(x, 32);
  return x;
}
DEV const float* xrow_in(const Params& p, int l, int row) {
  if (l > 0) return p.out + (size_t)row * DM;
  return row < M_PROMPT ? p.x_prompt + (size_t)row * DM : p.x_sample + (size_t)(row - M_PROMPT) * DM;
}

DEV void conv_phase(const Params& p, int l, char* smem_raw, int bid, int nb) {
  h16* lds = (h16*)smem_raw;
  const int tid = threadIdx.x;
  constexpr int NT0 = 62 * 16, NT1 = 64 * 16, NT2 = 64 * 4, NT3 = 16 * 16, NT4 = 88 * 16, NT5 = 16 * 44;
  constexpr int total = NT0 + NT1 + NT2 + NT3 + NT4 + NT5;
  for (int id = bid; id < total; id += nb) {
    int job = 0, r = id;
    if (r >= NT0) { r -= NT0; job = 1;
      if (r >= NT1) { r -= NT1; job = 2;
        if (r >= NT2) { r -= NT2; job = 3;
          if (r >= NT3) { r -= NT3; job = 4;
            if (r >= NT4) { r -= NT4; job = 5; } } } } }
    int K, ld; const float* src; h16* dst;
    switch (job) {
      case 0: K = 1024; ld = 7952; src = p.w_in + (size_t)l * 1024 * 7952; dst = p.WT + WT_IN; break;
      case 1: K = 1024; ld = 7952; src = p.w_in + (size_t)l * 1024 * 7952; dst = p.WT + WT_G; break;
      case 2: K = 256; ld = 1024; src = p.w_branch + (size_t)l * 4 * 256 * 1024; dst = p.WT + WT_BR; break;
      case 3: K = 1024; ld = 1024; src = p.w_out + (size_t)l * 1024 * 1024; dst = p.WT + WT_OUT; break;
      case 4: K = 1024; ld = 5632; src = p.w_ffn_in + (size_t)l * 1024 * 5632; dst = p.WT + WT_FIN; break;
      default: K = 2816; ld = 1024; src = p.w_ffn_out + (size_t)l * 2816 * 1024; dst = p.WT + WT_FOUT; break;
    }
    const int nkt = K / 64, nt_ = r / nkt, kt = r % nkt, n0 = nt_ * 64, k0 = kt * 64;
    {
      const int n4 = (tid & 15) * 4, kk = tid >> 4;
      const int n16 = n0 + (n4 & ~15);
      int col; const float* s = src;
      switch (job) {
        case 0: col = n16 < 3856 ? n16 : -1; break;
        case 1: col = 3856 + n16; break;
        case 2: s = src + (size_t)(n16 >> 10) * 256 * 1024; col = n16 & 1023; break;
        case 4: { int tile = n16 >> 7, wc = (n16 >> 6) & 1, sub = (n16 >> 4) & 3; col = (sub >> 1) * DFF + tile * 64 + wc * 32 + (sub & 1) * 16; } break;
        default: col = n16; break;
      }
#pragma unroll
      for (int i = 0; i < 4; ++i) {
        const int k = kk + 16 * i;
        float4 v = make_float4(0.f, 0.f, 0.f, 0.f);
        if (col >= 0) v = *(const float4*)(s + (size_t)(k0 + k) * ld + col + (n4 & 15));
        lds[(n4 + 0) * 72 + k] = (h16)v.x; lds[(n4 + 1) * 72 + k] = (h16)v.y;
        lds[(n4 + 2) * 72 + k] = (h16)v.z; lds[(n4 + 3) * 72 + k] = (h16)v.w;
      }
    }
    __syncthreads();
    {
      const int n = tid >> 2, kc = (tid & 3) * 16;
      const uint4 a = *(const uint4*)(lds + n * 72 + kc), b = *(const uint4*)(lds + n * 72 + kc + 8);
      uint4* d = (uint4*)(dst + (size_t)(n0 + n) * K + k0 + kc);
      d[0] = a; d[1] = b;
    }
    __syncthreads();
  }
}

template <bool FINAL> DEV void norm_phase(const Params& p, int l, const float* w, int bid, int nb) {
  const int lane = threadIdx.x & 63, wv = threadIdx.x >> 6;
  for (int row = bid * 4 + wv; row < M_TOK; row += nb * 4) {
    const float* xr = FINAL ? p.out + (size_t)row * DM : xrow_in(p, l, row);
    float4 v[4]; float ss = 0.f;
#pragma unroll
    for (int i = 0; i < 4; ++i) { v[i] = *(const float4*)(xr + i * 256 + lane * 4); ss += v[i].x * v[i].x + v[i].y * v[i].y + v[i].z * v[i].z + v[i].w * v[i].w; }
    ss = wave_sum(ss);
    const float rs = rsqrtf(ss * (1.f / 1024.f) + 1e-6f);
#pragma unroll
    for (int i = 0; i < 4; ++i) {
      const float4 ww = *(const float4*)(w + i * 256 + lane * 4);
      const float a = v[i].x * rs * ww.x, b = v[i].y * rs * ww.y, c = v[i].z * rs * ww.z, d = v[i].w * rs * ww.w;
      if (FINAL) *(float4*)(p.out + (size_t)row * DM + i * 256 + lane * 4) = make_float4(a, b, c, d);
      else { h16x4 o = {(h16)a, (h16)b, (h16)c, (h16)d}; *(h16x4*)(p.h + (size_t)row * DM + i * 256 + lane * 4) = o; }
    }
  }
}

template <int WN>
DEV void gemm_kloop(const h16* __restrict__ Ag, int lda, const h16* __restrict__ Bg, int ldb, int nk, f32x4 (&acc)[4][WN], char* smem) {
  constexpr int BN = 32 * WN, BCH = BN / 32, STG = (128 + BN) * 128;
  const int tid = threadIdx.x, lane = tid & 63, wave = tid >> 6, wr = wave >> 1, wc = wave & 1;
  const int r0 = tid >> 3, c0 = tid & 7;
  const h16* ap = Ag + (size_t)r0 * lda + c0 * 8;
  const h16* bp = Bg + (size_t)r0 * ldb + c0 * 8;
  const int wofs = r0 * 128 + ((c0 ^ ((r0 >> 1) & 7)) << 4);
  uint4 ra[4], rb[BCH];
  const int sw = (lane >> 1) & 7, q = lane >> 4;
  const int fo0 = (lane & 15) * 128 + (((q) ^ sw) << 4), fo1 = (lane & 15) * 128 + (((4 + q) ^ sw) << 4);
  const int aoff = wr * 64 * 128, boff = 128 * 128 + wc * (16 * WN) * 128;

#define G_LOAD(kt) do { _Pragma("unroll") for (int i = 0; i < 4; ++i) ra[i] = *(const uint4*)(ap + (size_t)(32 * i) * lda + (kt) * 64); \
                        _Pragma("unroll") for (int i = 0; i < BCH; ++i) rb[i] = *(const uint4*)(bp + (size_t)(32 * i) * ldb + (kt) * 64); } while (0)
#define S_STORE(buf) do { char* s_ = smem + (buf) * STG; \
                        _Pragma("unroll") for (int i = 0; i < 4; ++i) *(uint4*)(s_ + wofs + i * 4096) = ra[i]; \
                        _Pragma("unroll") for (int i = 0; i < BCH; ++i) *(uint4*)(s_ + 16384 + wofs + i * 4096) = rb[i]; } while (0)
  G_LOAD(0);
  S_STORE(0);
  __syncthreads();
  for (int kt = 0; kt < nk; ++kt) {
    const int cur = kt & 1;
    if (kt + 1 < nk) G_LOAD(kt + 1);
    const char* s_ = smem + cur * STG;
#pragma unroll
    for (int ks = 0; ks < 2; ++ks) {
      const int fo = ks ? fo1 : fo0;
      h16x8 af[4], bf[WN];
#pragma unroll
      for (int m = 0; m < 4; ++m) af[m] = *(const h16x8*)(s_ + aoff + m * 2048 + fo);
#pragma unroll
      for (int n = 0; n < WN; ++n) bf[n] = *(const h16x8*)(s_ + boff + n * 2048 + fo);
#pragma unroll
      for (int m = 0; m < 4; ++m)
#pragma unroll
        for (int n = 0; n < WN; ++n) acc[m][n] = __builtin_amdgcn_mfma_f32_16x16x32_f16(bf[n], af[m], acc[m][n], 0, 0, 0);
    }
    if (kt + 1 < nk) S_STORE(cur ^ 1);
    __syncthreads();
  }
#undef G_LOAD
#undef S_STORE
}

DEV void tile_coords(int id, int NT, int& tm, int& tn) { const int per = 8 * NT, g = id / per, r = id - g * per; tm = g * 8 + (r & 7); tn = r >> 3; }

DEV void gemm1_phase(const Params& p, char* smem, int bid, int nb) {
  const int lane = threadIdx.x & 63, wave = threadIdx.x >> 6, wr = wave >> 1, wc = wave & 1;
  for (int id = bid; id < 136 * 31; id += nb) {
    int tm, tn; tile_coords(id, 31, tm, tn);
    f32x4 acc[4][4];
#pragma unroll
    for (int m = 0; m < 4; ++m)
#pragma unroll
      for (int n = 0; n < 4; ++n) acc[m][n] = (f32x4){0.f, 0.f, 0.f, 0.f};
    gemm_kloop<4>(p.h + (size_t)tm * 128 * DM, DM, p.WT + WT_IN + (size_t)tn * 128 * 1024, 1024, 16, acc, smem);
#pragma unroll
    for (int m = 0; m < 4; ++m) {
      const int row = tm * 128 + wr * 64 + m * 16 + (lane & 15);
#pragma unroll
      for (int n = 0; n < 4; ++n) {
        const int col = tn * 128 + wc * 64 + n * 16 + (lane >> 4) * 4;
        if (col < NPC) { h16x4 o = {(h16)acc[m][n][0], (h16)acc[m][n][1], (h16)acc[m][n][2], (h16)acc[m][n][3]}; *(h16x4*)(p.P + (size_t)row * NPC + col) = o; }
      }
    }
  }
}

DEV void gemm2_phase(const Params& p, char* smem, int bid, int nb) {
  const int lane = threadIdx.x & 63, wave = threadIdx.x >> 6, wr = wave >> 1, wc = wave & 1;
  h16* merged = p.P;
  for (int id = bid; id < 136 * 16; id += nb) {
    int tm, tn; tile_coords(id, 16, tm, tn);
    f32x4 mg[4][2];
#pragma unroll
    for (int m = 0; m < 4; ++m) { mg[m][0] = (f32x4){0.f, 0.f, 0.f, 0.f}; mg[m][1] = mg[m][0]; }
    for (int b = 0; b < 4; ++b) {
      f32x4 g[4][2], u[4][2];
#pragma unroll
      for (int m = 0; m < 4; ++m) { g[m][0] = (f32x4){0.f, 0.f, 0.f, 0.f}; g[m][1] = g[m][0]; u[m][0] = g[m][0]; u[m][1] = g[m][0]; }
      gemm_kloop<2>(p.h + (size_t)tm * 128 * DM, DM, p.WT + WT_G + (size_t)(b * 1024 + tn * 64) * 1024, 1024, 16, g, smem);
      gemm_kloop<2>(p.o + (size_t)tm * 128 * DM + b * 256, DM, p.WT + WT_BR + (size_t)(b * 1024 + tn * 64) * 256, 256, 4, u, smem);
#pragma unroll
      for (int m = 0; m < 4; ++m)
#pragma unroll
        for (int n = 0; n < 2; ++n)
#pragma unroll
          for (int j = 0; j < 4; ++j) mg[m][n][j] += sigm(g[m][n][j]) * u[m][n][j];
    }
#pragma unroll
    for (int m = 0; m < 4; ++m) {
      const int row = tm * 128 + wr * 64 + m * 16 + (lane & 15);
#pragma unroll
      for (int n = 0; n < 2; ++n) {
        const int col = tn * 64 + wc * 32 + n * 16 + (lane >> 4) * 4;
        h16x4 o = {(h16)mg[m][n][0], (h16)mg[m][n][1], (h16)mg[m][n][2], (h16)mg[m][n][3]};
        *(h16x4*)(merged + (size_t)row * DM + col) = o;
      }
    }
  }
}

DEV void gemm_res_phase(const Params& p, int l, bool first, const h16* A, int lda, const h16* Wt, int nk, char* smem, int bid, int nb) {
  const int lane = threadIdx.x & 63, wave = threadIdx.x >> 6, wr = wave >> 1, wc = wave & 1;
  for (int id = bid; id < 136 * 8; id += nb) {
    int tm, tn; tile_coords(id, 8, tm, tn);
    f32x4 acc[4][4];
#pragma unroll
    for (int m = 0; m < 4; ++m)
#pragma unroll
      for (int n = 0; n < 4; ++n) acc[m][n] = (f32x4){0.f, 0.f, 0.f, 0.f};
    gemm_kloop<4>(A + (size_t)tm * 128 * lda, lda, Wt + (size_t)tn * 128 * (nk * 64), nk * 64, nk, acc, smem);
#pragma unroll
    for (int m = 0; m < 4; ++m) {
      const int row = tm * 128 + wr * 64 + m * 16 + (lane & 15);
      const float* xin = first ? xrow_in(p, l, row) : p.out + (size_t)row * DM;
      float* xo = p.out + (size_t)row * DM;
#pragma unroll
      for (int n = 0; n < 4; ++n) {
        const int col = tn * 128 + wc * 64 + n * 16 + (lane >> 4) * 4;
        const float4 xv = *(const float4*)(xin + col);
        *(float4*)(xo + col) = make_float4(xv.x + acc[m][n][0], xv.y + acc[m][n][1], xv.z + acc[m][n][2], xv.w + acc[m][n][3]);
      }
    }
  }
}

DEV void gemm4_phase(const Params& p, char* smem, int bid, int nb) {
  const int lane = threadIdx.x & 63, wave = threadIdx.x >> 6, wr = wave >> 1, wc = wave & 1;
  h16* act = p.P;
  for (int id = bid; id < 136 * 44; id += nb) {
    int tm, tn; tile_coords(id, 44, tm, tn);
    f32x4 acc[4][4];
#pragma unroll
    for (int m = 0; m < 4; ++m)
#pragma unroll
      for (int n = 0; n < 4; ++n) acc[m][n] = (f32x4){0.f, 0.f, 0.f, 0.f};
    gemm_kloop<4>(p.h + (size_t)tm * 128 * DM, DM, p.WT + WT_FIN + (size_t)tn * 128 * 1024, 1024, 16, acc, smem);
#pragma unroll
    for (int m = 0; m < 4; ++m) {
      const int row = tm * 128 + wr * 64 + m * 16 + (lane & 15);
#pragma unroll
      for (int n = 0; n < 2; ++n) {
        const int hid = tn * 64 + wc * 32 + n * 16 + (lane >> 4) * 4;
        h16x4 o;
#pragma unroll
        for (int j = 0; j < 4; ++j) o[j] = (h16)(silu(acc[m][n][j]) * acc[m][n + 2][j]);
        *(h16x4*)(act + (size_t)row * DFF + hid) = o;
      }
    }
  }
}

DEV void prep_phase(const Params& p, int l, char* smem, int bid, int nb) {
  float* s_wd = (float*)smem;
  float* s_ad = s_wd + 16 * 64;
  const int tid = threadIdx.x;
  const float* mu = p.rw_mu + l * 1024;
  if (l == 0) {
    for (int e = bid * 256 + tid; e < 2056 * 32; e += nb * 256) {
      const int pi = e >> 5, i = e & 31;
      const float pos = pi < 2048 ? (float)pi : (float)(16384 + pi - 2048);
      const float inv = powf(10000.f, -(float)i / 32.f);
      const float ang = pos * inv;
      double rev = (double)ang * 0.15915494309189535;
      rev -= rint(rev);
      p.rope[pi * 64 + i] = __builtin_amdgcn_cosf((float)rev);
      p.rope[pi * 64 + 32 + i] = __builtin_amdgcn_sinf((float)rev);
    }
  }
  for (int s = bid; s < 136; s += nb) {
    const int tok = s < 8 ? s * 2048 + 2047 : M_PROMPT + (s - 8) * 8 + 7;
    float* dst = s < 8 ? p.out + O_PSH + (size_t)(l * 8 + s) * 1024 : p.out + O_SSH + (size_t)(l * 128 + (s - 8)) * 1024;
    for (int c = tid; c < 1024; c += 256) dst[c] = (float)p.P[(size_t)tok * NPC + C_RW + c];
  }
  const float* w2 = p.rw_w2 + (size_t)l * 64 * 256;
  const float* a2 = p.rw_a2 + (size_t)l * 64 * 256;
  for (int tile = bid; tile < M_TOK / 16; tile += nb) {
    const int tok0 = tile * 16;
    {
      const int tt = tid >> 4, c8 = (tid & 15) * 8, tok = tok0 + tt;
      const int col = c8 < 64 ? 256 + c8 : 832 + (c8 - 64);
      int tpos, b;
      if (tok < M_PROMPT) { tpos = tok & 2047; b = -1; } else { tpos = (tok - M_PROMPT) & 7; b = (tok - M_PROMPT) >> 3; }
      const h16x8 cur = *(const h16x8*)(p.P + (size_t)tok * NPC + C_RW + col);
      float pv[8];
      if (tpos > 0) { const h16x8 pr = *(const h16x8*)(p.P + (size_t)(tok - 1) * NPC + C_RW + col);
#pragma unroll
        for (int i = 0; i < 8; ++i) pv[i] = (float)pr[i]; }
      else if (b >= 0) {
#pragma unroll
        for (int i = 0; i < 8; ++i) pv[i] = p.st_shift[(size_t)(l * 128 + b) * 1024 + col + i]; }
      else {
#pragma unroll
        for (int i = 0; i < 8; ++i) pv[i] = 0.f; }
#pragma unroll
      for (int i = 0; i < 8; ++i) {
        const float c = (float)cur[i];
        float mval = c + (pv[i] - c) * mu[col + i];
        if (c8 < 64) s_wd[tt * 64 + c8 + i] = tanhf(mval); else s_ad[tt * 64 + (c8 - 64) + i] = mval;
      }
    }
    __syncthreads();
    {
      const int j = tid;
      float aw[16], aa[16];
#pragma unroll
      for (int t = 0; t < 16; ++t) { aw[t] = 0.f; aa[t] = 0.f; }
      for (int k = 0; k < 64; k += 4) {
        float wv[4], av[4];
#pragma unroll
        for (int kk = 0; kk < 4; ++kk) { wv[kk] = w2[(k + kk) * 256 + j]; av[kk] = a2[(k + kk) * 256 + j]; }
#pragma unroll
        for (int t = 0; t < 16; ++t) {
          const float4 x = *(const float4*)(s_wd + t * 64 + k), y = *(const float4*)(s_ad + t * 64 + k);
          aw[t] += x.x * wv[0] + x.y * wv[1] + x.z * wv[2] + x.w * wv[3];
          aa[t] += y.x * av[0] + y.y * av[1] + y.z * av[2] + y.w * av[3];
        }
      }
      const float w0 = p.rw_w0[l * 256 + j], a0 = p.rw_a0[l * 256 + j];
#pragma unroll
      for (int t = 0; t < 16; ++t) {
        const float lw = -0.6065306597126334f * sigm(w0 + aw[t]);
        p.RWp[(size_t)(tok0 + t) * 512 + j] = (h16)__expf(lw);
        p.RWp[(size_t)(tok0 + t) * 512 + 256 + j] = (h16)sigm(a0 + aa[t]);
      }
    }
    __syncthreads();
  }
}

struct Raw { h16x4 a, b, c, d, e, f; h16 v, vp; h16x8 g0, g1; };

template <int MX> DEV void recur_item(const Params& p, int l, int s, int hd, int vq, char* smem) {
  constexpr int DK = (MX == 1) ? 32 : 64, KPL = DK / 16, T = 16;
  constexpr int BUF = (5 * T * 64 + 2 * T * 16) * 4;
  const int tid = threadIdx.x, lane = tid & 63, wave = tid >> 6, vl = lane >> 4, kg = lane & 15;
  const bool prompt = s < 8;
  const int L = prompt ? 2048 : 8, tok0 = prompt ? s * 2048 : M_PROMPT + (s - 8) * 8, b = prompt ? s : s - 8;
  const int pos0 = prompt ? 0 : 2048;
  const int st = tid >> 4, sj = tid & 15;
  const int vcol = vq * 16 + wave * 4 + vl;

  float c0[4] = {0.f, 0.f, 0.f, 0.f}, c1[4] = {0.f, 0.f, 0.f, 0.f}, c2[4] = {0.f, 0.f, 0.f, 0.f}, c3[4] = {0.f, 0.f, 0.f, 0.f}, cv = 0.f;
  float wa[2][16]; float ba[2] = {0.f, 0.f};
  if (MX == 0) {
#pragma unroll
    for (int i = 0; i < 4; ++i) { const int c = hd * 64 + sj * 4 + i; c0[i] = l == 0 ? 0.f : 1.f / (1.f + __expf(p.hg_lb_logits[c] - p.hg_lb_logits[256 + c])); }
  } else if (MX == 1) {
#pragma unroll
    for (int i = 0; i < 2; ++i) { const int c = hd * 32 + sj * 2 + i; ba[i] = p.gla_ba[l * 128 + c];
#pragma unroll
      for (int r = 0; r < 16; ++r) wa[i][r] = p.gla_wa2[(size_t)l * 2048 + r * 128 + c]; }
  } else if (MX == 2) {
#pragma unroll
    for (int i = 0; i < 4; ++i) { const int c = hd * 64 + sj * 4 + i; c0[i] = p.rw_mu[l * 1024 + c]; c1[i] = p.rw_mu[l * 1024 + 320 + c]; c2[i] = p.rw_ka[l * 256 + c]; c3[i] = p.rw_kk[l * 256 + c]; }
    cv = p.rw_mu[l * 1024 + 576 + hd * 64 + vq * 16 + sj];
  }
  (void)wa; (void)ba; (void)c1; (void)c2; (void)c3; (void)cv;

  float S[KPL];
  {
    const float* sp = nullptr;
    if (!prompt) {
      if (MX == 0) sp = p.st_hg + ((size_t)(l * 128 + b) * 4 + hd) * 64 * 64;
      if (MX == 1) sp = p.st_gla + ((size_t)(l * 128 + b) * 4 + hd) * 32 * 64;
      if (MX == 2) sp = p.st_rw + ((size_t)(l * 128 + b) * 4 + hd) * 64 * 64;
      if (MX == 3) sp = p.st_ret + ((size_t)(l * 128 + b) * 4 + hd) * 64 * 64;
    }
#pragma unroll
    for (int i = 0; i < KPL; ++i) S[i] = prompt ? 0.f : sp[(kg * KPL + i) * 64 + vcol];
  }
  const float gam = 1.f - exp2f(-5.f - (float)hd);

  auto load_raw = [&](int tb, Raw& r) {
    const int t = tb + st;
    if (t >= L) return;
    const h16* pr = p.P + (size_t)(tok0 + t) * NPC;
    if (MX == 0) {
      r.a = *(const h16x4*)(pr + C_HGQ + hd * 64 + sj * 4); r.b = *(const h16x4*)(pr + C_HGF + hd * 64 + sj * 4);
      r.v = pr[C_HGI + hd * 64 + vq * 16 + sj];
    } else if (MX == 1) {
      const h16x2 q2 = *(const h16x2*)(pr + C_GLQ + hd * 32 + sj * 2), k2 = *(const h16x2*)(pr + C_GLK + hd * 32 + sj * 2);
      r.a[0] = q2[0]; r.a[1] = q2[1]; r.a[2] = k2[0]; r.a[3] = k2[1];
      r.g0 = *(const h16x8*)(pr + C_GLA); r.g1 = *(const h16x8*)(pr + C_GLA + 8);
      r.v = pr[C_GLV + hd * 64 + vq * 16 + sj];
    } else if (MX == 2) {
      r.a = *(const h16x4*)(pr + C_RW + hd * 64 + sj * 4); r.b = *(const h16x4*)(pr + C_RW + 320 + hd * 64 + sj * 4);
      r.v = pr[C_RW + 576 + hd * 64 + vq * 16 + sj];
      if (t > 0) {
        r.c = *(const h16x4*)(pr - NPC + C_RW + hd * 64 + sj * 4); r.d = *(const h16x4*)(pr - NPC + C_RW + 320 + hd * 64 + sj * 4);
        r.vp = *(pr - NPC + C_RW + 576 + hd * 64 + vq * 16 + sj);
      } else if (!prompt) {
        const float* sh = p.st_shift + (size_t)(l * 128 + b) * 1024;
#pragma unroll
        for (int i = 0; i < 4; ++i) { r.c[i] = (h16)0.f; r.d[i] = (h16)0.f; }
        (void)sh; r.vp = (h16)0.f;
      } else {
#pragma unroll
        for (int i = 0; i < 4; ++i) { r.c[i] = (h16)0.f; r.d[i] = (h16)0.f; }
        r.vp = (h16)0.f;
      }
      const h16* rw = p.RWp + (size_t)(tok0 + t) * 512;
      r.e = *(const h16x4*)(rw + hd * 64 + sj * 4); r.f = *(const h16x4*)(rw + 256 + hd * 64 + sj * 4);
    } else {
      const int base = sj < 8 ? C_RTQ : C_RTK, i4 = (sj & 7) * 4;
      r.a = *(const h16x4*)(pr + base + hd * 64 + i4); r.b = *(const h16x4*)(pr + base + hd * 64 + 32 + i4);
      r.v = pr[C_RTV + hd * 64 + vq * 16 + sj];
    }
  };

  auto process = [&](int tb, const Raw& r, char* buf) {
    float* sq = (float*)buf; float* sk = sq + T * 64; float* sg = sk + T * 64; float* skk = sg + T * 64; float* sak = skk + T * 64;
    float* sv = sak + T * 64;
    const int t = tb + st;
    const bool valid = t < L;
    if (MX == 0) {
      if (valid) {
        float4 qo, ko, go;
        float* qp = (float*)&qo; float* kp = (float*)&ko; float* gp = (float*)&go;
#pragma unroll
        for (int i = 0; i < 4; ++i) {
          const float f = c0[i] + (1.f - c0[i]) * sigm((float)r.b[i]);
          qp[i] = silu((float)r.a[i]); kp[i] = 1.f - f; gp[i] = fmaxf(f, 1e-30f);
        }
        *(float4*)(sq + st * 64 + sj * 4) = qo; *(float4*)(sk + st * 64 + sj * 4) = ko; *(float4*)(sg + st * 64 + sj * 4) = go;
        sv[st * 16 + sj] = (float)r.v;
      }
    } else if (MX == 1) {
      if (valid) {
#pragma unroll
        for (int i = 0; i < 2; ++i) {
          float z = ba[i];
#pragma unroll
          for (int rr = 0; rr < 8; ++rr) z += (float)r.g0[rr] * wa[i][rr] + (float)r.g1[rr] * wa[i][8 + rr];
          const float ls = fminf(z, 0.f) - log1pf(__expf(-fabsf(z)));
          sq[st * 64 + sj * 2 + i] = (float)r.a[i] * 0.17677669529663687f;
          sk[st * 64 + sj * 2 + i] = (float)r.a[2 + i];
          sg[st * 64 + sj * 2 + i] = __expf(ls * 0.0625f);
        }
        sv[st * 16 + sj] = (float)r.v;
      }
    } else if (MX == 2) {
      float rr[4], kk[4], kr[4], ak[4], ww[4], ss = 0.f, vv = 0.f;
      if (valid) {
        float pc[4], pd[4], pvv = (float)r.vp;
#pragma unroll
        for (int i = 0; i < 4; ++i) { pc[i] = (float)r.c[i]; pd[i] = (float)r.d[i]; }
        if (t == 0 && !prompt) {
          const float* sh = p.st_shift + (size_t)(l * 128 + b) * 1024;
#pragma unroll
          for (int i = 0; i < 4; ++i) { pc[i] = sh[hd * 64 + sj * 4 + i]; pd[i] = sh[320 + hd * 64 + sj * 4 + i]; }
          pvv = sh[576 + hd * 64 + vq * 16 + sj];
        }
#pragma unroll
        for (int i = 0; i < 4; ++i) {
          const float rc = (float)r.a[i], kc = (float)r.b[i];
          rr[i] = rc + (pc[i] - rc) * c0[i];
          const float km = kc + (pd[i] - kc) * c1[i];
          const float a = (float)r.f[i];
          ww[i] = (float)r.e[i];
          kk[i] = km * (1.f + (a - 1.f) * c2[i]);
          kr[i] = km * c3[i];
          ak[i] = a;
          ss += kr[i] * kr[i];
        }
        const float vc = (float)r.v;
        vv = vc + (pvv - vc) * cv;
      } else {
#pragma unroll
        for (int i = 0; i < 4; ++i) { rr[i] = kk[i] = kr[i] = ak[i] = ww[i] = 0.f; }
      }
      ss = row16_sum(ss);
      if (valid) {
        const float inv = 1.f / fmaxf(sqrtf(ss), 1e-12f);
        float4 o0 = make_float4(rr[0], rr[1], rr[2], rr[3]), o1 = make_float4(kk[0], kk[1], kk[2], kk[3]), o2 = make_float4(ww[0], ww[1], ww[2], ww[3]);
        float4 o3 = make_float4(kr[0] * inv, kr[1] * inv, kr[2] * inv, kr[3] * inv);
        float4 o4 = make_float4(o3.x * ak[0], o3.y * ak[1], o3.z * ak[2], o3.w * ak[3]);
        *(float4*)(sq + st * 64 + sj * 4) = o0; *(float4*)(sk + st * 64 + sj * 4) = o1; *(float4*)(sg + st * 64 + sj * 4) = o2;
        *(float4*)(skk + st * 64 + sj * 4) = o3; *(float4*)(sak + st * 64 + sj * 4) = o4;
        sv[st * 16 + sj] = vv;
      }
    } else {
      if (valid) {
        const int i4 = (sj & 7) * 4;
        const float* rp = p.rope + (size_t)(pos0 + t) * 64;
        const float4 cs = *(const float4*)(rp + i4), sn = *(const float4*)(rp + 32 + i4);
        const float* cp = (const float*)&cs; const float* sp = (const float*)&sn;
        const float sc = sj < 8 ? 1.f : 0.125f;
        float* dst = sj < 8 ? sq : sk;
        float4 o1, o2; float* p1 = (float*)&o1; float* p2 = (float*)&o2;
#pragma unroll
        for (int i = 0; i < 4; ++i) {
          const float x1 = (float)r.a[i], x2 = (float)r.b[i];
          p1[i] = (x1 * cp[i] - x2 * sp[i]) * sc; p2[i] = (x1 * sp[i] + x2 * cp[i]) * sc;
        }
        *(float4*)(dst + st * 64 + i4) = o1; *(float4*)(dst + st * 64 + 32 + i4) = o2;
        sv[st * 16 + sj] = (float)r.v;
      }
    }
  };

  auto flush = [&](int tb, const char* buf) {
    const float* so = (const float*)buf + 5 * T * 64 + T * 16;
    const int t = tb + st;
    if (t < L) p.o[(size_t)(tok0 + t) * DM + MX * 256 + hd * 64 + vq * 16 + sj] = (h16)so[st * 16 + sj];
  };

  const int nbat = (L + T - 1) / T;
  Raw raw;
  load_raw(0, raw);
  for (int bt = 0; bt < nbat; ++bt) {
    char* buf = smem + (bt & 1) * BUF;
    process(bt * T, raw, buf);
    __syncthreads();
    if (bt > 0) flush((bt - 1) * T, smem + ((bt - 1) & 1) * BUF);
    if (bt + 1 < nbat) load_raw((bt + 1) * T, raw);
    {
      const float* sq = (const float*)buf; const float* sk = sq + T * 64; const float* sg = sk + T * 64; const float* skk = sg + T * 64;
      const float* sak = skk + T * 64; const float* sv = sak + T * 64; float* so = (float*)sv + T * 16;
      const int nt = min(T, L - bt * T);
      for (int t = 0; t < nt; ++t) {
        const float vv = sv[t * 16 + wave * 4 + vl];
        float part = 0.f;
        if constexpr (MX == 2) {
          const float4 r4 = *(const float4*)(sq + t * 64 + kg * 4), k4 = *(const float4*)(sk + t * 64 + kg * 4), w4 = *(const float4*)(sg + t * 64 + kg * 4);
          const float4 n4 = *(const float4*)(skk + t * 64 + kg * 4), a4 = *(const float4*)(sak + t * 64 + kg * 4);
          float ks = n4.x * S[0] + n4.y * S[1] + n4.z * S[2] + n4.w * S[3];
          ks = row16_sum(ks);
          S[0] = w4.x * S[0] + (k4.x * vv - a4.x * ks);
          S[1] = w4.y * S[1] + (k4.y * vv - a4.y * ks);
          S[2] = w4.z * S[2] + (k4.z * vv - a4.z * ks);
          S[3] = w4.w * S[3] + (k4.w * vv - a4.w * ks);
          part = r4.x * S[0] + r4.y * S[1] + r4.z * S[2] + r4.w * S[3];
        } else if constexpr (MX == 1) {
          const float2 q2 = *(const float2*)(sq + t * 64 + kg * 2), k2 = *(const float2*)(sk + t * 64 + kg * 2), g2 = *(const float2*)(sg + t * 64 + kg * 2);
          S[0] = g2.x * S[0] + k2.x * vv; S[1] = g2.y * S[1] + k2.y * vv;
          part = q2.x * S[0] + q2.y * S[1];
        } else {
          const float4 q4 = *(const float4*)(sq + t * 64 + kg * 4), k4 = *(const float4*)(sk + t * 64 + kg * 4);
          float4 g4;
          if (MX == 0) g4 = *(const float4*)(sg + t * 64 + kg * 4); else g4 = make_float4(gam, gam, gam, gam);
          S[0] = g4.x * S[0] + k4.x * vv; S[1] = g4.y * S[1] + k4.y * vv; S[2] = g4.z * S[2] + k4.z * vv; S[3] = g4.w * S[3] + k4.w * vv;
          part = q4.x * S[0] + q4.y * S[1] + q4.z * S[2] + q4.w * S[3];
        }
        part = row16_sum(part);
        if (kg == 0) so[t * 16 + wave * 4 + vl] = part;
      }
    }
  }
  __syncthreads();
  flush((nbat - 1) * T, smem + ((nbat - 1) & 1) * BUF);
  {
    float* dp;
    if (MX == 0) dp = p.out + (prompt ? O_PHG + ((size_t)(l * 8 + b) * 4 + hd) * 4096 : O_SHG + ((size_t)(l * 128 + b) * 4 + hd) * 4096);
    else if (MX == 1) dp = p.out + (prompt ? O_PGLA + ((size_t)(l * 8 + b) * 4 + hd) * 2048 : O_SGLA + ((size_t)(l * 128 + b) * 4 + hd) * 2048);
    else if (MX == 2) dp = p.out + (prompt ? O_PRW + ((size_t)(l * 8 + b) * 4 + hd) * 4096 : O_SRW + ((size_t)(l * 128 + b) * 4 + hd) * 4096);
    else dp = p.out + (prompt ? O_PRET + ((size_t)(l * 8 + b) * 4 + hd) * 4096 : O_SRET + ((size_t)(l * 128 + b) * 4 + hd) * 4096);
#pragma unroll
    for (int i = 0; i < KPL; ++i) dp[(kg * KPL + i) * 64 + vcol] = S[i];
  }
  __syncthreads();
}

DEV void recur_phase(const Params& p, int l, char* smem, int bid, int nb) {
  int* s_idx = (int*)(smem + 65536 - 16);
  const int total = 512 + 8192;
  for (;;) {
    if (threadIdx.x == 0) *s_idx = (int)atomicAdd(p.ctr + l, 1u);
    __syncthreads();
    const int idx = *s_idx;
    __syncthreads();
    if (idx >= total) break;
    int mx, s, hd, vq;
    if (idx < 128) { mx = 2; s = idx >> 4; hd = (idx >> 2) & 3; vq = idx & 3; }
    else if (idx < 512) { const int r = idx - 128, mi = r >> 7; mx = mi == 0 ? 0 : (mi == 1 ? 1 : 3); s = (r & 127) >> 4; hd = (r >> 2) & 3; vq = r & 3; }
    else { const int r = idx - 512; mx = r >> 11; const int rem = r & 2047; s = 8 + (rem >> 4); hd = (rem >> 2) & 3; vq = rem & 3; }
    if (mx == 0) recur_item<0>(p, l, s, hd, vq, smem);
    else if (mx == 1) recur_item<1>(p, l, s, hd, vq, smem);
    else if (mx == 2) recur_item<2>(p, l, s, hd, vq, smem);
    else recur_item<3>(p, l, s, hd, vq, smem);
  }
}

DEV void post_phase(const Params& p, int l, char* smem, int bid, int nb) {
  float* s_g = (float*)smem;
  const int tid = threadIdx.x, j = tid;
  const float* mu = p.rw_mu + l * 1024;
  const float* g2 = p.rw_g2 + (size_t)l * 128 * 256;
  const float hgw = p.hg_norm_w[l * 64 + (j & 63)], glw = p.gla_norm_w[l * 64 + (j & 63)];
  const float lnw = p.rw_ln_w[l * 256 + j], lnb = p.rw_ln_b[l * 256 + j], rk = p.rw_rk[l * 256 + j], ka = p.rw_ka[l * 256 + j];
  const float mur = mu[j], muk = mu[320 + j], muv = mu[576 + j];
  for (int tile = bid; tile < M_TOK / 16; tile += nb) {
    const int tok0 = tile * 16;
    {
      const int tt = tid >> 4, c8 = (tid & 15) * 8, tok = tok0 + tt;
      int tpos, b;
      if (tok < M_PROMPT) { tpos = tok & 2047; b = -1; } else { tpos = (tok - M_PROMPT) & 7; b = (tok - M_PROMPT) >> 3; }
      const h16x8 cur = *(const h16x8*)(p.P + (size_t)tok * NPC + C_RW + 896 + c8);
      float pv[8];
      if (tpos > 0) { const h16x8 pr = *(const h16x8*)(p.P + (size_t)(tok - 1) * NPC + C_RW + 896 + c8);
#pragma unroll
        for (int i = 0; i < 8; ++i) pv[i] = (float)pr[i]; }
      else if (b >= 0) {
#pragma unroll
        for (int i = 0; i < 8; ++i) pv[i] = p.st_shift[(size_t)(l * 128 + b) * 1024 + 896 + c8 + i]; }
      else {
#pragma unroll
        for (int i = 0; i < 8; ++i) pv[i] = 0.f; }
#pragma unroll
      for (int i = 0; i < 8; ++i) { const float c = (float)cur[i]; s_g[tt * 128 + c8 + i] = sigm(c + (pv[i] - c) * mu[896 + c8 + i]); }
    }
    __syncthreads();
    float ag[16];
#pragma unroll
    for (int t = 0; t < 16; ++t) ag[t] = 0.f;
    for (int k = 0; k < 128; k += 4) {
      float gv[4];
#pragma unroll
      for (int kk = 0; kk < 4; ++kk) gv[kk] = g2[(k + kk) * 256 + j];
#pragma unroll
      for (int t = 0; t < 16; ++t) { const float4 x = *(const float4*)(s_g + t * 128 + k); ag[t] += x.x * gv[0] + x.y * gv[1] + x.z * gv[2] + x.w * gv[3]; }
    }
    float* s_ag = s_g + 16 * 128;
#pragma unroll
    for (int t = 0; t < 16; ++t) s_ag[t * 256 + j] = ag[t];
    for (int t = 0; t < 16; ++t) {
      const int tok = tok0 + t;
      const h16* pr = p.P + (size_t)tok * NPC;
      h16* op = p.o + (size_t)tok * DM;
      int tpos, b;
      if (tok < M_PROMPT) { tpos = tok & 2047; b = -1; } else { tpos = (tok - M_PROMPT) & 7; b = (tok - M_PROMPT) >> 3; }
      {
        const float o = (float)op[j];
        const float ms = wave_sum(o * o) * (1.f / 64.f);
        op[j] = (h16)(o * rsqrtf(ms + 1e-6f) * hgw * silu((float)pr[C_HGG + j]));
      }
      {
        const float o = (float)op[256 + j];
        const float ms = wave_sum(o * o) * (1.f / 64.f);
        op[256 + j] = (h16)(o * rsqrtf(ms + 1e-6f) * glw * silu((float)pr[C_GLG + j]));
      }
      {
        const float o = (float)op[512 + j];
        const float mean = wave_sum(o) * (1.f / 64.f);
        const float d = o - mean;
        const float var = wave_sum(d * d) * (1.f / 64.f);
        float y = d * rsqrtf(var + 64e-5f) * lnw + lnb;
        float rc = (float)pr[C_RW + j], kc = (float)pr[C_RW + 320 + j], vc = (float)pr[C_RW + 576 + j];
        float rp, kp, vp;
        if (tpos > 0) { rp = (float)pr[C_RW + j - NPC]; kp = (float)pr[C_RW + 320 + j - NPC]; vp = (float)pr[C_RW + 576 + j - NPC]; }
        else if (b >= 0) { const float* sh = p.st_shift + (size_t)(l * 128 + b) * 1024; rp = sh[j]; kp = sh[320 + j]; vp = sh[576 + j]; }
        else { rp = kp = vp = 0.f; }
        const float r = rc + (rp - rc) * mur, km = kc + (kp - kc) * muk, v = vc + (vp - vc) * muv;
        const float a = (float)p.RWp[(size_t)tok * 512 + 256 + j];
        const float k2 = km * (1.f + (a - 1.f) * ka);
        const float bs = wave_sum(r * k2 * rk);
        y = (y + bs * v) * s_ag[t * 256 + j];
        op[512 + j] = (h16)y;
      }
      {
        const float o = (float)op[768 + j];
        const float ms = wave_sum(o * o) * (1.f / 64.f);
        op[768 + j] = (h16)(o * rsqrtf(ms + 1e-6f) * silu((float)pr[C_RTG + j]));
      }
    }
    __syncthreads();
  }
}

constexpr int N_PHASE = 22;
DEV void run_phase(const Params& p, int ph, char* smem, int bid, int nb) {
  if (ph == 0) { conv_phase(p, 0, smem, bid, nb); norm_phase<false>(p, 0, p.attn_norm_w, bid, nb); return; }
  if (ph == 21) { norm_phase<true>(p, 1, p.final_norm_w, bid, nb); return; }
  const int l = (ph - 1) / 10, s = (ph - 1) % 10;
  switch (s) {
    case 0: gemm1_phase(p, smem, bid, nb); break;
    case 1: prep_phase(p, l, smem, bid, nb); break;
    case 2: recur_phase(p, l, smem, bid, nb); break;
    case 3: post_phase(p, l, smem, bid, nb); break;
    case 4: gemm2_phase(p, smem, bid, nb); break;
    case 5: gemm_res_phase(p, l, l == 0, p.P, DM, p.WT + WT_OUT, 16, smem, bid, nb); break;
    case 6: norm_phase<false>(p, 1, p.ffn_norm_w + l * DM, bid, nb); break;
    case 7: gemm4_phase(p, smem, bid, nb); break;
    case 8: gemm_res_phase(p, 1, false, p.P, DFF, p.WT + WT_FOUT, 44, smem, bid, nb); break;
    default:
      if (l == 0) { conv_phase(p, 1, smem, bid, nb); norm_phase<false>(p, 1, p.attn_norm_w + DM, bid, nb); }
      break;
  }
}

#if !MEGA
__global__ void __launch_bounds__(256, 2) k_single(Params p, int ph) {
  __shared__ __attribute__((aligned(16))) char smem[65536];
  run_phase(p, ph, smem, blockIdx.x, gridDim.x);
}

#else
__global__ void __launch_bounds__(256, 2) k_mega(Params p) {
  __shared__ __attribute__((aligned(16))) char smem[65536];
  cg::grid_group grid = cg::this_grid();
  for (int ph = 0; ph < N_PHASE; ++ph) {
    if (ph == 20) continue;
    run_phase(p, ph, smem, blockIdx.x, gridDim.x);
    if (ph != N_PHASE - 1) grid.sync();
  }
}

#endif

extern "C" void kernel_launch(void* const* d_in, const int* in_sizes, int n_in, void* d_out, int out_size, void* d_ws, size_t ws_size,
                              hipStream_t stream) {
  (void)in_sizes; (void)n_in; (void)out_size;
  if (ws_size < WS_END) { fprintf(stderr, "workspace too small: %zu < %zu\n", ws_size, (size_t)WS_END); return; }
  Params p{};
  const float** f = (const float**)&p;
  for (int i = 0; i < 31; ++i) f[i] = (const float*)d_in[i];
  p.out = (float*)d_out;
  char* ws = (char*)d_ws;
  p.WT = (h16*)(ws + WS_WT); p.h = (h16*)(ws + WS_H); p.o = (h16*)(ws + WS_O); p.P = (h16*)(ws + WS_P); p.RWp = (h16*)(ws + WS_RWP);
  p.rope = (float*)(ws + WS_ROPE); p.ctr = (unsigned*)(ws + WS_CTR);
  static int grid_blocks = 0;
  if (!grid_blocks) {
    int dev = 0, cus = 0, per_cu = 0;
    (void)hipGetDevice(&dev);
    (void)hipDeviceGetAttribute(&cus, hipDeviceAttributeMultiprocessorCount, dev);
#if MEGA
    (void)hipOccupancyMaxActiveBlocksPerMultiprocessor(&per_cu, k_mega, 256, 0);
#else
    (void)hipOccupancyMaxActiveBlocksPerMultiprocessor(&per_cu, k_single, 256, 0);
#endif
    if (per_cu < 1) per_cu = 1;
    if (per_cu > 2) per_cu = 2;
    grid_blocks = cus * per_cu;
  }
  (void)hipMemsetAsync(p.ctr, 0, 256, stream);
#if MEGA
  void* args[] = {&p};
  hipError_t e = hipLaunchCooperativeKernel((void*)k_mega, dim3(grid_blocks), dim3(256), args, 0, stream);
  if (e != hipSuccess) fprintf(stderr, "cooperative launch failed: %s (grid %d)\n", hipGetErrorString(e), grid_blocks);
#else
  for (int ph = 0; ph < N_PHASE; ++ph) {
    if (ph == 20) continue;
    k_single<<<grid_blocks, 256, 0, stream>>>(p, ph);
  }
#endif
}
```

```cpp
#include <hip/hip_runtime.h>
#include <hip/hip_cooperative_groups.h>
#include <cstdio>
namespace cg = cooperative_groups;

#ifndef MEGA
#define MEGA 1
#endif
#define PROBE_RECUR 0
#define PROBE_DUP 0

typedef _Float16 h16;
typedef _Float16 h16x8 __attribute__((ext_vector_type(8)));
typedef _Float16 h16x4 __attribute__((ext_vector_type(4)));
typedef _Float16 h16x2 __attribute__((ext_vector_type(2)));
typedef float f32x4 __attribute__((ext_vector_type(4)));
typedef unsigned u32x4 __attribute__((ext_vector_type(4)));
typedef float f32x2 __attribute__((ext_vector_type(2)));
#define DEV __device__ __forceinline__

constexpr int M_TOK = 17408, M_PROMPT = 16384, DM = 1024, NPC = 3856  , DFF = 2816;
constexpr int C_HGQ = 0, C_HGF = 256, C_HGI = 512, C_HGG = 768;
constexpr int C_GLQ = 1024, C_GLK = 1152, C_GLV = 1280, C_GLG = 1536, C_GLA = 3840;
constexpr int C_RW = 1792;
constexpr int C_RTQ = 2816, C_RTK = 3072, C_RTV = 3328, C_RTG = 3584;
constexpr size_t WT_IN = 0, WT_G = 4063232, WT_BR = 8257536, WT_OUT = 9306112, WT_FIN = 10354688, WT_FOUT = 16121856,
                 WT_TOTAL = 19005440;
constexpr size_t WS_WT = 0, WS_H = WS_WT + WT_TOTAL * 2, WS_O = WS_H + (size_t)M_TOK * DM * 2, WS_P = WS_O + (size_t)M_TOK * DM * 2,
                 WS_RWP = WS_P + (size_t)M_TOK * NPC * 2, WS_ROPE = WS_RWP + (size_t)M_TOK * 512 * 2,
                 WS_CTR = WS_ROPE + (size_t)2056 * 64 * 4, WS_BAR = WS_CTR + 256, WS_LORA = WS_BAR + 3456 * 4 + 256, WS_END = WS_LORA + (size_t)(256 * 128 + 2 * 256 * 64) * 2;
constexpr size_t O_PHG = 17825792, O_PGLA = 18087936, O_PRW = 18219008, O_PSH = 18481152, O_PRET = 18497536, O_SHG = 18759680,
                 O_SGLA = 22953984, O_SRW = 25051136, O_SSH = 29245440, O_SRET = 29507584;

struct Params {
  const float *x_prompt, *x_sample, *st_hg, *st_gla, *st_rw, *st_shift, *st_ret;
  const float *attn_norm_w, *w_in, *hg_lb_logits, *hg_norm_w, *gla_wa2, *gla_ba, *gla_norm_w;
  const float *rw_mu, *rw_w0, *rw_w2, *rw_a0, *rw_a2, *rw_g2, *rw_kk, *rw_ka, *rw_rk, *rw_ln_w, *rw_ln_b;
  const float *w_branch, *w_out, *ffn_norm_w, *w_ffn_in, *w_ffn_out, *final_norm_w;
  float* out;
  h16 *WT, *h, *o, *P, *RWp;
  float* rope;
  unsigned* ctr;
  unsigned* bar;
  h16* lora;
};

DEV int tidx() { int t = threadIdx.x; asm volatile("" : "+v"(t)); return t; }
DEV float sigm(float x) { return __builtin_amdgcn_rcpf(1.f + __expf(-x)); }
DEV float silu(float x) { return x * sigm(x); }
template <int CTRL> DEV float dpp_f(float x) {
  return __int_as_float(__builtin_amdgcn_update_dpp(0, __float_as_int(x), CTRL, 0xf, 0xf, false));
}
DEV float row16_sum(float x) {
  x += dpp_f<0x128>(x); x += dpp_f<0x124>(x); x += dpp_f<0x122>(x); x += dpp_f<0x121>(x);
  return x;
}
DEV float wave_sum(float x) {
  x = row16_sum(x);
  x += __shfl_xor(x, 16);
  x += __shfl_xor(x, 32);
  return x;
}
DEV const float* xrow_in(const Params& p, int l, int row) {
  if (l > 0) return p.out + (size_t)row * DM;
  return row < M_PROMPT ? p.x_prompt + (size_t)row * DM : p.x_sample + (size_t)(row - M_PROMPT) * DM;
}

DEV void conv_phase(const Params& p, int l, char* smem_raw, int bid, int nb) {
  h16* lds = (h16*)smem_raw;
  const int tid = tidx();
  for (int e = bid * 256 + tid; e < 256 * 16 + 2 * 256 * 8; e += nb * 256) {
    const float* src; h16* dst; int K, col, k8;
    if (e < 256 * 16) { src = p.rw_g2 + (size_t)l * 128 * 256; dst = p.lora; K = 128; col = e >> 4; k8 = (e & 15) * 8; }
    else { const int r = e - 256 * 16, mtx = r >> 11, q = r & 2047; src = (mtx ? p.rw_a2 : p.rw_w2) + (size_t)l * 64 * 256; dst = p.lora + 256 * 128 + mtx * 256 * 64; K = 64; col = q >> 3; k8 = (q & 7) * 8; }
    h16x8 o;
#pragma unroll
    for (int i = 0; i < 8; ++i) o[i] = (h16)src[(size_t)(k8 + i) * 256 + col];
    *(h16x8*)(dst + (size_t)col * K + k8) = o;
  }
  constexpr int NT0 = 62 * 16, NT1 = 64 * 16, NT2 = 16 * 16, NT3 = 16 * 16, NT4 = 88 * 16, NT5 = 16 * 44;
  constexpr int total = NT0 + NT1 + NT2 + NT3 + NT4 + NT5;
  for (int id = bid; id < total; id += nb) {
    int job = 0, r = id;
    if (r >= NT0) { r -= NT0; job = 1;
      if (r >= NT1) { r -= NT1; job = 2;
        if (r >= NT2) { r -= NT2; job = 3;
          if (r >= NT3) { r -= NT3; job = 4;
            if (r >= NT4) { r -= NT4; job = 5; } } } } }
    int K, ld; const float* src; h16* dst;
    switch (job) {
      case 0: K = 1024; ld = 7952; src = p.w_in + (size_t)l * 1024 * 7952; dst = p.WT + WT_IN; break;
      case 1: K = 1024; ld = 7952; src = p.w_in + (size_t)l * 1024 * 7952; dst = p.WT + WT_G; break;
      case 2: K = 1024; ld = 1024; src = p.w_branch + (size_t)l * 4 * 256 * 1024; dst = p.WT + WT_BR; break;
      case 3: K = 1024; ld = 1024; src = p.w_out + (size_t)l * 1024 * 1024; dst = p.WT + WT_OUT; break;
      case 4: K = 1024; ld = 5632; src = p.w_ffn_in + (size_t)l * 1024 * 5632; dst = p.WT + WT_FIN; break;
      default: K = 2816; ld = 1024; src = p.w_ffn_out + (size_t)l * 2816 * 1024; dst = p.WT + WT_FOUT; break;
    }
    const int nkt = K / 64, nt_ = r / nkt, kt = r % nkt, n0 = nt_ * 64, k0 = kt * 64;
    {
      const int n4 = (tid & 15) * 4, kk = tid >> 4;
      const int n16 = n0 + (n4 & ~15);
      int col; const float* s = src;
      switch (job) {
        case 0: col = n16 < 1536 ? n16 : (n16 < 3840 ? n16 + 16 : (n16 == 3840 ? 1536 : -1)); break;
        case 1: col = 3856 + n16; break;
        case 4: { int tile = n16 >> 7, wc = (n16 >> 6) & 1, sub = (n16 >> 4) & 3; col = (sub >> 1) * DFF + tile * 64 + wc * 32 + (sub & 1) * 16; } break;
        default: col = n16; break;
      }
#pragma unroll
      for (int i = 0; i < 4; ++i) {
        const int k = kk + 16 * i;
        float4 v = make_float4(0.f, 0.f, 0.f, 0.f);
        if (col >= 0) { const f32x4 t_ = __builtin_nontemporal_load((const f32x4*)(s + (size_t)(k0 + k) * ld + col + (n4 & 15))); v = make_float4(t_[0], t_[1], t_[2], t_[3]); }
        lds[(n4 + 0) * 72 + k] = (h16)v.x; lds[(n4 + 1) * 72 + k] = (h16)v.y;
        lds[(n4 + 2) * 72 + k] = (h16)v.z; lds[(n4 + 3) * 72 + k] = (h16)v.w;
      }
    }
    __syncthreads();
    {
      const int n = tid >> 2, kc = (tid & 3) * 16;
      const uint4 a = *(const uint4*)(lds + n * 72 + kc), b = *(const uint4*)(lds + n * 72 + kc + 8);
      uint4* d = (uint4*)(dst + (size_t)(n0 + n) * K + k0 + kc);
      d[0] = a; d[1] = b;
    }
    __syncthreads();
  }
}

template <bool FINAL> DEV void norm_phase(const Params& p, int l, const float* w, int bid, int nb) {
  const int lane = tidx() & 63, wv = tidx() >> 6;
  for (int row0 = bid * 4 + wv; row0 < M_TOK; row0 += nb * 8) {
    const int row1 = row0 + nb * 4;
    const bool has1 = row1 < M_TOK;
    const float* xr0 = FINAL ? p.out + (size_t)row0 * DM : xrow_in(p, l, row0);
    const float* xr1 = has1 ? (FINAL ? p.out + (size_t)row1 * DM : xrow_in(p, l, row1)) : xr0;
    float4 v0[4], v1[4], ww[4]; float s0 = 0.f, s1 = 0.f;
#pragma unroll
    for (int i = 0; i < 4; ++i) {
      v0[i] = *(const float4*)(xr0 + i * 256 + lane * 4); v1[i] = *(const float4*)(xr1 + i * 256 + lane * 4);
      ww[i] = *(const float4*)(w + i * 256 + lane * 4);
    }
#pragma unroll
    for (int i = 0; i < 4; ++i) {
      s0 += v0[i].x * v0[i].x + v0[i].y * v0[i].y + v0[i].z * v0[i].z + v0[i].w * v0[i].w;
      s1 += v1[i].x * v1[i].x + v1[i].y * v1[i].y + v1[i].z * v1[i].z + v1[i].w * v1[i].w;
    }
    s0 = wave_sum(s0); s1 = wave_sum(s1);
    const float r0 = rsqrtf(s0 * (1.f / 1024.f) + 1e-6f), r1 = rsqrtf(s1 * (1.f / 1024.f) + 1e-6f);
#pragma unroll
    for (int i = 0; i < 4; ++i) {
      {
        const float a = v0[i].x * r0 * ww[i].x, b = v0[i].y * r0 * ww[i].y, c = v0[i].z * r0 * ww[i].z, d = v0[i].w * r0 * ww[i].w;
        if (FINAL) *(float4*)(p.out + (size_t)row0 * DM + i * 256 + lane * 4) = make_float4(a, b, c, d);
        else { h16x4 o = {(h16)a, (h16)b, (h16)c, (h16)d}; *(h16x4*)(p.h + (size_t)row0 * DM + i * 256 + lane * 4) = o; }
      }
      if (has1) {
        const float a = v1[i].x * r1 * ww[i].x, b = v1[i].y * r1 * ww[i].y, c = v1[i].z * r1 * ww[i].z, d = v1[i].w * r1 * ww[i].w;
        if (FINAL) *(float4*)(p.out + (size_t)row1 * DM + i * 256 + lane * 4) = make_float4(a, b, c, d);
        else { h16x4 o = {(h16)a, (h16)b, (h16)c, (h16)d}; *(h16x4*)(p.h + (size_t)row1 * DM + i * 256 + lane * 4) = o; }
      }
    }
  }
}

struct NoHook { DEV void prefetch(int) {} DEV void apply(int) {} };
template <int WN, int LDA, int LDB, int NK, int PF = 2, int HOOK = 0, class HookT = NoHook>
DEV void gemm_kloop(const h16* __restrict__ Ag, const h16* __restrict__ Bg, f32x4 (&acc)[4][WN], char* smem, HookT hook = HookT()) {
  static_assert(NK % 2 == 0, "NK must be even");
  constexpr int BN = 32 * WN, BCH = BN / 32, STG = (128 + BN) * 128;
  const int tid = tidx(), lane = tid & 63, wave = tid >> 6, wr = wave >> 1, wc = wave & 1;
  const int r0 = tid >> 3, c0 = tid & 7;
  const char* Ab = (const char*)Ag;
  const char* Bb = (const char*)Bg;
  const unsigned aofs = (unsigned)(r0 * LDA + c0 * 8) * 2u, bofs = (unsigned)(r0 * LDB + c0 * 8) * 2u;
  const int wofs = r0 * 128 + ((c0 ^ ((r0 >> 1) & 7)) << 4);
  u32x4 ra0[4], rb0[BCH], ra1[4], rb1[BCH];
  const int sw = (lane >> 1) & 7, q = lane >> 4;
  const int fo0 = (lane & 15) * 128 + (((q) ^ sw) << 4), fo1 = (lane & 15) * 128 + (((4 + q) ^ sw) << 4);
  const int aoff = wr * 64 * 128, boff = 128 * 128 + wc * (16 * WN) * 128;

  auto g_load = [&](u32x4 (&RA)[4], u32x4 (&RB)[BCH], int kt) {
#pragma unroll
    for (int i = 0; i < 4; ++i) RA[i] = *(const u32x4*)(Ab + (size_t)kt * 128 + (aofs + (unsigned)(i * 32 * LDA * 2)));
#pragma unroll
    for (int i = 0; i < BCH; ++i) RB[i] = *(const u32x4*)(Bb + (size_t)kt * 128 + (bofs + (unsigned)(i * 32 * LDB * 2)));
  };
  auto s_store = [&](const u32x4 (&RA)[4], const u32x4 (&RB)[BCH], int buf) {
    char* s_ = smem + buf * STG;
#pragma unroll
    for (int i = 0; i < 4; ++i) *(u32x4*)(s_ + wofs + i * 4096) = RA[i];
#pragma unroll
    for (int i = 0; i < BCH; ++i) *(u32x4*)(s_ + 16384 + wofs + i * 4096) = RB[i];
  };
  auto compute = [&](int buf) {
    const char* s_ = smem + buf * STG;
    if constexpr (HOOK != 0) {
#pragma unroll
      for (int ks = 0; ks < 2; ++ks) {
        const int fo = ks ? fo1 : fo0;
        h16x8 af[4], bf[WN];
#pragma unroll
        for (int m = 0; m < 4; ++m) af[m] = *(const h16x8*)(s_ + aoff + m * 2048 + fo);
#pragma unroll
        for (int n = 0; n < WN; ++n) bf[n] = *(const h16x8*)(s_ + boff + n * 2048 + fo);
        __builtin_amdgcn_sched_barrier(0);
#pragma unroll
        for (int m = 0; m < 4; ++m)
#pragma unroll
          for (int n = 0; n < WN; ++n) acc[m][n] = __builtin_amdgcn_mfma_f32_16x16x32_f16(bf[n], af[m], acc[m][n], 0, 0, 0);
        __builtin_amdgcn_sched_barrier(0);
      }
    } else {
    h16x8 af[2][4], bf[2][WN];
#pragma unroll
    for (int ks = 0; ks < 2; ++ks) {
      const int fo = ks ? fo1 : fo0;
#pragma unroll
      for (int m = 0; m < 4; ++m) af[ks][m] = *(const h16x8*)(s_ + aoff + m * 2048 + fo);
#pragma unroll
      for (int n = 0; n < WN; ++n) bf[ks][n] = *(const h16x8*)(s_ + boff + n * 2048 + fo);
    }
    __builtin_amdgcn_sched_barrier(0);
#pragma unroll
    for (int ks = 0; ks < 2; ++ks)
#pragma unroll
      for (int m = 0; m < 4; ++m)
#pragma unroll
        for (int n = 0; n < WN; ++n) acc[m][n] = __builtin_amdgcn_mfma_f32_16x16x32_f16(bf[ks][n], af[ks][m], acc[m][n], 0, 0, 0);
    __builtin_amdgcn_sched_barrier(0);
    }
  };
  if constexpr (PF == 3) {
    const unsigned c0s = (unsigned)(c0 ^ ((r0 >> 1) & 7));
    const unsigned aofd = (unsigned)(r0 * LDA) * 2u + c0s * 16u, bofd = (unsigned)(r0 * LDB) * 2u + c0s * 16u;
    auto dma = [&](int kt, int buf) {
      char* s_ = smem + buf * STG + tid * 16;
#pragma unroll
      for (int i = 0; i < 4; ++i)
        __builtin_amdgcn_global_load_lds((const unsigned*)(Ab + (size_t)kt * 128 + (aofd + (unsigned)(i * 32 * LDA * 2))), (unsigned*)(s_ + i * 4096), 16, 0, 0);
#pragma unroll
      for (int i = 0; i < BCH; ++i)
        __builtin_amdgcn_global_load_lds((const unsigned*)(Bb + (size_t)kt * 128 + (bofd + (unsigned)(i * 32 * LDB * 2))), (unsigned*)(s_ + 16384 + i * 4096), 16, 0, 0);
    };
    dma(0, 0);
#pragma nounroll
    for (int kt = 0; kt < NK; kt += 2) {
      asm volatile("s_waitcnt vmcnt(0)" ::: "memory");
      __syncthreads();
      dma(kt + 1, 1);
      if (HOOK && (kt & 3) == 0) hook.prefetch(kt >> 2);
      compute(0);
      asm volatile("s_waitcnt vmcnt(0)" ::: "memory");
      __syncthreads();
      if (kt + 2 < NK) dma(kt + 2, 0);
      compute(1);
      if (HOOK && (kt & 3) == 2) hook.apply(kt >> 2);
    }
    __syncthreads();
  } else if constexpr (PF == 2) {
    g_load(ra0, rb0, 0);
    g_load(ra1, rb1, 1);
    s_store(ra0, rb0, 0);
    __syncthreads();
#pragma nounroll
    for (int kt = 0; kt < NK; kt += 2) {
      if (kt + 2 < NK) g_load(ra0, rb0, kt + 2);
      if (HOOK && (kt & 3) == 0) hook.prefetch(kt >> 2);
      compute(0);
      s_store(ra1, rb1, 1);
      __syncthreads();
      if (kt + 3 < NK) g_load(ra1, rb1, kt + 3);
      compute(1);
      if (kt + 2 < NK) s_store(ra0, rb0, 0);
      if (HOOK && (kt & 3) == 2) hook.apply(kt >> 2);
      __syncthreads();
    }
  } else {
    g_load(ra0, rb0, 0);
    s_store(ra0, rb0, 0);
    __syncthreads();
#pragma nounroll
    for (int kt = 0; kt < NK; kt += 2) {
      g_load(ra0, rb0, kt + 1);
      compute(0);
      s_store(ra0, rb0, 1);
      __syncthreads();
      if (kt + 2 < NK) g_load(ra0, rb0, kt + 2);
      compute(1);
      if (kt + 2 < NK) s_store(ra0, rb0, 0);
      __syncthreads();
    }
  }
}

template <int NTM, int NTN, class F> DEV void for_tiles_xcd(int bid, int nb, F f) {
  static_assert(NTM % 8 == 0, "row panels must split evenly over 8 XCDs");
  if ((nb & 7) != 0) { for (int id = bid; id < NTM * NTN; id += nb) f(id % NTM, id / NTM); return; }
  constexpr int PM = NTM / 8;
  const int xcd = bid & 7, nloc = nb >> 3;
  for (int i = bid >> 3; i < PM * NTN; i += nloc) {
    const int tn = i / PM, pm = i - tn * PM;
    f(pm * 8 + xcd, tn);
  }
}
DEV void tile_coords(int id, int NT, int& tm, int& tn) { const int per = 8 * NT, g = id / per, r = id - g * per; tm = g * 8 + (r & 7); tn = r >> 3; }

DEV void gemm1_phase(const Params& p, char* smem, int bid, int nb) {
  const int lane = tidx() & 63, wave = tidx() >> 6, wr = wave >> 1, wc = wave & 1;
  for_tiles_xcd<136, 30>(bid, nb, [&](int tm, int tn) {
    f32x4 acc[4][4];
#pragma unroll
    for (int m = 0; m < 4; ++m)
#pragma unroll
      for (int n = 0; n < 4; ++n) acc[m][n] = (f32x4){0.f, 0.f, 0.f, 0.f};
    gemm_kloop<4, DM, 1024, 16, 3>(p.h + (size_t)tm * 128 * DM, p.WT + WT_IN + (size_t)tn * 128 * 1024, acc, smem);
#pragma unroll
    for (int m = 0; m < 4; ++m) {
      const int row = tm * 128 + wr * 64 + m * 16 + (lane & 15);
#pragma unroll
      for (int n = 0; n < 4; ++n) {
        const int col = tn * 128 + wc * 64 + n * 16 + (lane >> 4) * 4;
        { h16x4 o = {(h16)acc[m][n][0], (h16)acc[m][n][1], (h16)acc[m][n][2], (h16)acc[m][n][3]}; *(h16x4*)(p.P + (size_t)row * NPC + col) = o; }
      }
    }
  });
}

DEV void gemmG_phase(const Params& p, char* smem, int bid, int nb) {
  const int lane = tidx() & 63, wave = tidx() >> 6, wr = wave >> 1, wc = wave & 1;
  h16* G = p.P;
  for_tiles_xcd<136, 32>(bid, nb, [&](int tm, int tn) {
    f32x4 acc[4][4];
#pragma unroll
    for (int m = 0; m < 4; ++m)
#pragma unroll
      for (int n = 0; n < 4; ++n) acc[m][n] = (f32x4){0.f, 0.f, 0.f, 0.f};
    gemm_kloop<4, DM, 1024, 16, 3>(p.h + (size_t)tm * 128 * DM, p.WT + WT_G + (size_t)tn * 128 * 1024, acc, smem);
#pragma unroll
    for (int m = 0; m < 4; ++m) {
      const int row = tm * 128 + wr * 64 + m * 16 + (lane & 15);
#pragma unroll
      for (int n = 0; n < 4; ++n) {
        const int col = tn * 128 + wc * 64 + n * 16 + (lane >> 4) * 4;
        h16x4 o = {(h16)sigm(acc[m][n][0]), (h16)sigm(acc[m][n][1]), (h16)sigm(acc[m][n][2]), (h16)sigm(acc[m][n][3])};
        *(h16x4*)(G + (size_t)row * 4096 + col) = o;
      }
    }
  });
}

struct MergeHook {
  f32x4 (&acc)[4][2]; f32x4 (&mg)[4][2]; h16x4 (&gt)[4][2]; const h16* gp;
  DEV void prefetch(int b) {
#pragma unroll
    for (int m = 0; m < 4; ++m)
#pragma unroll
      for (int n = 0; n < 2; ++n) gt[m][n] = *(const h16x4*)(gp + (size_t)m * 16 * 4096 + b * 1024 + n * 16);
  }
  DEV void apply(int) {
#pragma unroll
    for (int m = 0; m < 4; ++m)
#pragma unroll
      for (int n = 0; n < 2; ++n) {
#pragma unroll
        for (int j = 0; j < 4; ++j) mg[m][n][j] += (float)gt[m][n][j] * acc[m][n][j];
        acc[m][n] = (f32x4){0.f, 0.f, 0.f, 0.f};
      }
  }
};
struct MergeHook4 {
  f32x4 (&acc)[4][4]; f32x4 (&mg)[4][4]; const h16* gp;
  DEV void prefetch(int) {}
  DEV void apply(int b) {
#pragma unroll
    for (int m = 0; m < 4; ++m) {
      h16x4 gt[4];
#pragma unroll
      for (int n = 0; n < 4; ++n) gt[n] = *(const h16x4*)(gp + (size_t)m * 16 * 4096 + b * 1024 + n * 16);
#pragma unroll
      for (int n = 0; n < 4; ++n) {
#pragma unroll
        for (int j = 0; j < 4; ++j) mg[m][n][j] += (float)gt[n][j] * acc[m][n][j];
        acc[m][n] = (f32x4){0.f, 0.f, 0.f, 0.f};
      }
    }
  }
};
DEV void gemmU_phase(const Params& p, char* smem, int bid, int nb) {
  const int lane = tidx() & 63, wave = tidx() >> 6, wr = wave >> 1, wc = wave & 1;
  const h16* G = p.P;
  h16* merged = p.h;
  for_tiles_xcd<136, 8>(bid, nb, [&](int tm, int tn) {
    f32x4 mg[4][4], acc[4][4];
#pragma unroll
    for (int m = 0; m < 4; ++m)
#pragma unroll
      for (int n = 0; n < 4; ++n) { mg[m][n] = (f32x4){0.f, 0.f, 0.f, 0.f}; acc[m][n] = mg[m][n]; }
    const int row0 = tm * 128 + wr * 64 + (lane & 15), col0 = tn * 128 + wc * 64 + (lane >> 4) * 4;
    MergeHook4 hook{acc, mg, G + (size_t)row0 * 4096 + col0};
    gemm_kloop<4, DM, 1024, 16, 3, 1, MergeHook4>(p.o + (size_t)tm * 128 * DM, p.WT + WT_BR + (size_t)(tn * 128) * 1024, acc, smem, hook);
#pragma unroll
    for (int m = 0; m < 4; ++m)
#pragma unroll
      for (int n = 0; n < 4; ++n) {
        h16x4 o = {(h16)mg[m][n][0], (h16)mg[m][n][1], (h16)mg[m][n][2], (h16)mg[m][n][3]};
        *(h16x4*)(merged + (size_t)(row0 + m * 16) * DM + col0 + n * 16) = o;
      }
  });
}

template <int NK>
DEV void gemm_res_phase(const Params& p, int l, bool first, const h16* A, const h16* Wt, char* smem, int bid, int nb) {
  const int lane = tidx() & 63, wave = tidx() >> 6, wr = wave >> 1, wc = wave & 1;
  for_tiles_xcd<136, 8>(bid, nb, [&](int tm, int tn) {
    f32x4 acc[4][4];
#pragma unroll
    for (int m = 0; m < 4; ++m)
#pragma unroll
      for (int n = 0; n < 4; ++n) acc[m][n] = (f32x4){0.f, 0.f, 0.f, 0.f};
    gemm_kloop<4, NK * 64, NK * 64, NK, 3>(A + (size_t)tm * 128 * (NK * 64), Wt + (size_t)tn * 128 * (NK * 64), acc, smem);
#pragma unroll
    for (int m = 0; m < 4; ++m) {
      const int row = tm * 128 + wr * 64 + m * 16 + (lane & 15);
      const float* xin = first ? xrow_in(p, l, row) : p.out + (size_t)row * DM;
      float* xo = p.out + (size_t)row * DM;
#pragma unroll
      for (int n = 0; n < 4; ++n) {
        const int col = tn * 128 + wc * 64 + n * 16 + (lane >> 4) * 4;
        const float4 xv = *(const float4*)(xin + col);
        *(float4*)(xo + col) = make_float4(xv.x + acc[m][n][0], xv.y + acc[m][n][1], xv.z + acc[m][n][2], xv.w + acc[m][n][3]);
      }
    }
  });
}

DEV void gemm4_phase(const Params& p, char* smem, int bid, int nb) {
  const int lane = tidx() & 63, wave = tidx() >> 6, wr = wave >> 1, wc = wave & 1;
  h16* act = p.P;
  for_tiles_xcd<136, 44>(bid, nb, [&](int tm, int tn) {
    f32x4 acc[4][4];
#pragma unroll
    for (int m = 0; m < 4; ++m)
#pragma unroll
      for (int n = 0; n < 4; ++n) acc[m][n] = (f32x4){0.f, 0.f, 0.f, 0.f};
    gemm_kloop<4, DM, 1024, 16, 3>(p.h + (size_t)tm * 128 * DM, p.WT + WT_FIN + (size_t)tn * 128 * 1024, acc, smem);
#pragma unroll
    for (int m = 0; m < 4; ++m) {
      const int row = tm * 128 + wr * 64 + m * 16 + (lane & 15);
#pragma unroll
      for (int n = 0; n < 2; ++n) {
        const int hid = tn * 64 + wc * 32 + n * 16 + (lane >> 4) * 4;
        h16x4 o;
#pragma unroll
        for (int j = 0; j < 4; ++j) o[j] = (h16)(silu(acc[m][n][j]) * acc[m][n + 2][j]);
        *(h16x4*)(act + (size_t)row * DFF + hid) = o;
      }
    }
  });
}

DEV void prep_phase(const Params& p, int l, char* smem, int bid, int nb) {
  h16* s_wd16 = (h16*)smem;
  h16* s_ad16 = s_wd16 + 16 * 72;
  const int tid = tidx();
  const float* mu = p.rw_mu + l * 1024;
  if (l == 0) {
    for (int e = bid * 256 + tid; e < 2056 * 32; e += nb * 256) {
      const int pi = e >> 5, i = e & 31;
      const float pos = pi < 2048 ? (float)pi : (float)(16384 + pi - 2048);
      const float inv = powf(10000.f, -(float)i / 32.f);
      const float ang = pos * inv;
      double rev = (double)ang * 0.15915494309189535;
      rev -= rint(rev);
      p.rope[pi * 64 + i] = __builtin_amdgcn_cosf((float)rev);
      p.rope[pi * 64 + 32 + i] = __builtin_amdgcn_sinf((float)rev);
    }
  }
  for (int s = bid; s < 136; s += nb) {
    const int tok = s < 8 ? s * 2048 + 2047 : M_PROMPT + (s - 8) * 8 + 7;
    float* dst = s < 8 ? p.out + O_PSH + (size_t)(l * 8 + s) * 1024 : p.out + O_SSH + (size_t)(l * 128 + (s - 8)) * 1024;
    for (int c = tid; c < 1024; c += 256) dst[c] = (float)p.P[(size_t)tok * NPC + C_RW + c];
  }
  for (int tile = bid; tile < M_TOK / 16; tile += nb) {
    const int tok0 = tile * 16;
    {
      const int tt = tid >> 4, c8 = (tid & 15) * 8, tok = tok0 + tt;
      const int col = c8 < 64 ? 256 + c8 : 832 + (c8 - 64);
      int tpos, b;
      if (tok < M_PROMPT) { tpos = tok & 2047; b = -1; } else { tpos = (tok - M_PROMPT) & 7; b = (tok - M_PROMPT) >> 3; }
      const h16x8 cur = *(const h16x8*)(p.P + (size_t)tok * NPC + C_RW + col);
      float pv[8];
      if (tpos > 0) { const h16x8 pr = *(const h16x8*)(p.P + (size_t)(tok - 1) * NPC + C_RW + col);
#pragma unroll
        for (int i = 0; i < 8; ++i) pv[i] = (float)pr[i]; }
      else if (b >= 0) {
#pragma unroll
        for (int i = 0; i < 8; ++i) pv[i] = p.st_shift[(size_t)(l * 128 + b) * 1024 + col + i]; }
      else {
#pragma unroll
        for (int i = 0; i < 8; ++i) pv[i] = 0.f; }
      h16x8 m8;
#pragma unroll
      for (int i = 0; i < 8; ++i) {
        const float c = (float)cur[i];
        float mval = c + (pv[i] - c) * mu[col + i];
        m8[i] = (h16)(c8 < 64 ? 1.f - 2.f * __builtin_amdgcn_rcpf(1.f + __expf(2.f * mval)) : mval);
      }
      *(h16x8*)((c8 < 64 ? s_wd16 : s_ad16) + tt * 72 + (c8 & 63)) = m8;
    }
    __syncthreads();
    {
      const int lane = tid & 63, wv = tid >> 6;
      h16x8 aw[2], aa[2];
#pragma unroll
      for (int ks = 0; ks < 2; ++ks) {
        aw[ks] = *(const h16x8*)(s_wd16 + (lane & 15) * 72 + ks * 32 + (lane >> 4) * 8);
        aa[ks] = *(const h16x8*)(s_ad16 + (lane & 15) * 72 + ks * 32 + (lane >> 4) * 8);
      }
#pragma unroll
      for (int ct = 0; ct < 4; ++ct) {
        const int col = (wv * 4 + ct) * 16 + (lane & 15);
        const h16* bw = p.lora + 256 * 128 + (size_t)col * 64 + (lane >> 4) * 8;
        const h16* ba_ = bw + 256 * 64;
        f32x4 cw = {0.f, 0.f, 0.f, 0.f}, ca = {0.f, 0.f, 0.f, 0.f};
#pragma unroll
        for (int ks = 0; ks < 2; ++ks) {
          cw = __builtin_amdgcn_mfma_f32_16x16x32_f16(aw[ks], *(const h16x8*)(bw + ks * 32), cw, 0, 0, 0);
          ca = __builtin_amdgcn_mfma_f32_16x16x32_f16(aa[ks], *(const h16x8*)(ba_ + ks * 32), ca, 0, 0, 0);
        }
        const float w0c = p.rw_w0[l * 256 + col], a0c = p.rw_a0[l * 256 + col];
#pragma unroll
        for (int r = 0; r < 4; ++r) {
          h16* dst = p.RWp + (size_t)(tok0 + (lane >> 4) * 4 + r) * 512 + col;
          dst[0] = (h16)__expf(-0.6065306597126334f * sigm(w0c + cw[r]));
          dst[256] = (h16)sigm(a0c + ca[r]);
        }
      }
    }
    {
      const int lane = tid & 63, wv = tid >> 6;
      float* s_pa = (float*)(smem + 8192);
      const h16* ha = p.h + (size_t)(tok0 + (lane & 15)) * DM + (lane >> 4) * 8;
      const h16* wb = p.WT + WT_IN + (size_t)(3840 + (lane & 15)) * 1024 + (lane >> 4) * 8;
      f32x4 c = {0.f, 0.f, 0.f, 0.f};
#pragma unroll
      for (int ks = 0; ks < 8; ++ks) c = __builtin_amdgcn_mfma_f32_16x16x32_f16(*(const h16x8*)(ha + (wv * 8 + ks) * 32), *(const h16x8*)(wb + (wv * 8 + ks) * 32), c, 0, 0, 0);
#pragma unroll
      for (int r = 0; r < 4; ++r) s_pa[(wv * 16 + (lane >> 4) * 4 + r) * 16 + (lane & 15)] = c[r];
      __syncthreads();
      const int t = tid >> 4, cc = tid & 15;
      const float v = s_pa[(0 * 16 + t) * 16 + cc] + s_pa[(1 * 16 + t) * 16 + cc] + s_pa[(2 * 16 + t) * 16 + cc] + s_pa[(3 * 16 + t) * 16 + cc];
      p.P[(size_t)(tok0 + t) * NPC + C_GLA + cc] = (h16)v;
    }
    __syncthreads();
  }
}

struct Raw { h16x4 a, b, c, d, e, f; h16 v, vp; h16x8 g0, g1; };

template <int MX> DEV void recur_item(const Params& p, int l, int s, int hd, int vq, char* smem) {
  constexpr int DK = (MX == 1) ? 32 : 64, KPL = DK / 16, T = 16;
  constexpr int BUF = (5 * T * 64 + 2 * T * 16) * 4;
  const int tid = tidx(), lane = tid & 63, wave = tid >> 6, vl = lane >> 4, kg = lane & 15;
  const bool prompt = s < 8;
  const int L = prompt ? 2048 : 8, tok0 = prompt ? s * 2048 : M_PROMPT + (s - 8) * 8, b = prompt ? s : s - 8;
  const int pos0 = prompt ? 0 : 2048;
  const int st = tid >> 4, sj = tid & 15;
  const int vcol = vq * 16 + wave * 4 + vl;

  float c0[4] = {0.f, 0.f, 0.f, 0.f}, c1[4] = {0.f, 0.f, 0.f, 0.f}, c2[4] = {0.f, 0.f, 0.f, 0.f}, c3[4] = {0.f, 0.f, 0.f, 0.f}, cv = 0.f;
  float wa[2][16]; float ba[2] = {0.f, 0.f};
  if (MX == 0) {
#pragma unroll
    for (int i = 0; i < 4; ++i) { const int c = hd * 64 + sj * 4 + i; c0[i] = l == 0 ? 0.f : 1.f / (1.f + __expf(p.hg_lb_logits[c] - p.hg_lb_logits[256 + c])); }
  } else if (MX == 1) {
#pragma unroll
    for (int i = 0; i < 2; ++i) { const int c = hd * 32 + sj * 2 + i; ba[i] = p.gla_ba[l * 128 + c];
#pragma unroll
      for (int r = 0; r < 16; ++r) wa[i][r] = p.gla_wa2[(size_t)l * 2048 + r * 128 + c]; }
  } else if (MX == 2) {
#pragma unroll
    for (int i = 0; i < 4; ++i) { const int c = hd * 64 + sj * 4 + i; c0[i] = p.rw_mu[l * 1024 + c]; c1[i] = p.rw_mu[l * 1024 + 320 + c]; c2[i] = p.rw_ka[l * 256 + c]; c3[i] = p.rw_kk[l * 256 + c]; }
    cv = p.rw_mu[l * 1024 + 576 + hd * 64 + vq * 16 + sj];
  }
  (void)wa; (void)ba; (void)c1; (void)c2; (void)c3; (void)cv;

  float S[KPL];
  {
    const float* sp = nullptr;
    if (!prompt) {
      if (MX == 0) sp = p.st_hg + ((size_t)(l * 128 + b) * 4 + hd) * 64 * 64;
      if (MX == 1) sp = p.st_gla + ((size_t)(l * 128 + b) * 4 + hd) * 32 * 64;
      if (MX == 2) sp = p.st_rw + ((size_t)(l * 128 + b) * 4 + hd) * 64 * 64;
      if (MX == 3) sp = p.st_ret + ((size_t)(l * 128 + b) * 4 + hd) * 64 * 64;
    }
#pragma unroll
    for (int i = 0; i < KPL; ++i) S[i] = prompt ? 0.f : sp[(kg * KPL + i) * 64 + vcol];
  }
  f32x2 SA = {S[0], S[1]}, SB = {S[KPL - 2], S[KPL - 1]};
  const float gam = 1.f - exp2f(-5.f - (float)hd);

  auto load_raw = [&](int tb, Raw& r) {
    const int t = tb + st;
    if (t >= L) return;
    const h16* pr = p.P + (size_t)(tok0 + t) * NPC;
    if (MX == 0) {
      r.a = *(const h16x4*)(pr + C_HGQ + hd * 64 + sj * 4); r.b = *(const h16x4*)(pr + C_HGF + hd * 64 + sj * 4);
      r.v = pr[C_HGI + hd * 64 + vq * 16 + sj];
    } else if (MX == 1) {
      const h16x2 q2 = *(const h16x2*)(pr + C_GLQ + hd * 32 + sj * 2), k2 = *(const h16x2*)(pr + C_GLK + hd * 32 + sj * 2);
      r.a[0] = q2[0]; r.a[1] = q2[1]; r.a[2] = k2[0]; r.a[3] = k2[1];
      r.g0 = *(const h16x8*)(pr + C_GLA); r.g1 = *(const h16x8*)(pr + C_GLA + 8);
      r.v = pr[C_GLV + hd * 64 + vq * 16 + sj];
    } else if (MX == 2) {
      r.a = *(const h16x4*)(pr + C_RW + hd * 64 + sj * 4); r.b = *(const h16x4*)(pr + C_RW + 320 + hd * 64 + sj * 4);
      r.v = pr[C_RW + 576 + hd * 64 + vq * 16 + sj];
      if (t > 0) {
        r.c = *(const h16x4*)(pr - NPC + C_RW + hd * 64 + sj * 4); r.d = *(const h16x4*)(pr - NPC + C_RW + 320 + hd * 64 + sj * 4);
        r.vp = *(pr - NPC + C_RW + 576 + hd * 64 + vq * 16 + sj);
      } else if (!prompt) {
        const float* sh = p.st_shift + (size_t)(l * 128 + b) * 1024;
#pragma unroll
        for (int i = 0; i < 4; ++i) { r.c[i] = (h16)0.f; r.d[i] = (h16)0.f; }
        (void)sh; r.vp = (h16)0.f;
      } else {
#pragma unroll
        for (int i = 0; i < 4; ++i) { r.c[i] = (h16)0.f; r.d[i] = (h16)0.f; }
        r.vp = (h16)0.f;
      }
      const h16* rw = p.RWp + (size_t)(tok0 + t) * 512;
      r.e = *(const h16x4*)(rw + hd * 64 + sj * 4); r.f = *(const h16x4*)(rw + 256 + hd * 64 + sj * 4);
    } else {
      const int base = sj < 8 ? C_RTQ : C_RTK, i4 = (sj & 7) * 4;
      r.a = *(const h16x4*)(pr + base + hd * 64 + i4); r.b = *(const h16x4*)(pr + base + hd * 64 + 32 + i4);
      r.v = pr[C_RTV + hd * 64 + vq * 16 + sj];
    }
  };

  auto process = [&](int tb, const Raw& r, char* buf) {
    float* sq = (float*)buf; float* sk = sq + T * 64; float* sg = sk + T * 64; float* skk = sg + T * 64; float* sak = skk + T * 64;
    float* sv = sak + T * 64;
    const int t = tb + st;
    const bool valid = t < L;
    if (MX == 0) {
      if (valid) {
        float4 qo, ko, go;
        float* qp = (float*)&qo; float* kp = (float*)&ko; float* gp = (float*)&go;
#pragma unroll
        for (int i = 0; i < 4; ++i) {
          const float f = c0[i] + (1.f - c0[i]) * sigm((float)r.b[i]);
          qp[i] = silu((float)r.a[i]); kp[i] = 1.f - f; gp[i] = fmaxf(f, 1e-30f);
        }
        *(float4*)(sq + st * 64 + sj * 4) = qo; *(float4*)(sk + st * 64 + sj * 4) = ko; *(float4*)(sg + st * 64 + sj * 4) = go;
        sv[st * 16 + sj] = (float)r.v;
      }
    } else if (MX == 1) {
      if (valid) {
#pragma unroll
        for (int i = 0; i < 2; ++i) {
          float z = ba[i];
#pragma unroll
          for (int rr = 0; rr < 8; ++rr) z += (float)r.g0[rr] * wa[i][rr] + (float)r.g1[rr] * wa[i][8 + rr];
          const float ls = fminf(z, 0.f) - __logf(1.f + __expf(-fabsf(z)));
          sq[st * 64 + sj * 2 + i] = (float)r.a[i] * 0.17677669529663687f;
          sk[st * 64 + sj * 2 + i] = (float)r.a[2 + i];
          sg[st * 64 + sj * 2 + i] = __expf(ls * 0.0625f);
        }
        sv[st * 16 + sj] = (float)r.v;
      }
    } else if (MX == 2) {
      float rr[4], kk[4], kr[4], ak[4], ww[4], ss = 0.f, vv = 0.f;
      if (valid) {
        float pc[4], pd[4], pvv = (float)r.vp;
#pragma unroll
        for (int i = 0; i < 4; ++i) { pc[i] = (float)r.c[i]; pd[i] = (float)r.d[i]; }
        if (t == 0 && !prompt) {
          const float* sh = p.st_shift + (size_t)(l * 128 + b) * 1024;
#pragma unroll
          for (int i = 0; i < 4; ++i) { pc[i] = sh[hd * 64 + sj * 4 + i]; pd[i] = sh[320 + hd * 64 + sj * 4 + i]; }
          pvv = sh[576 + hd * 64 + vq * 16 + sj];
        }
#pragma unroll
        for (int i = 0; i < 4; ++i) {
          const float rc = (float)r.a[i], kc = (float)r.b[i];
          rr[i] = rc + (pc[i] - rc) * c0[i];
          const float km = kc + (pd[i] - kc) * c1[i];
          const float a = (float)r.f[i];
          ww[i] = (float)r.e[i];
          kk[i] = km * (1.f + (a - 1.f) * c2[i]);
          kr[i] = km * c3[i];
          ak[i] = a;
          ss += kr[i] * kr[i];
        }
        const float vc = (float)r.v;
        vv = vc + (pvv - vc) * cv;
      } else {
#pragma unroll
        for (int i = 0; i < 4; ++i) { rr[i] = kk[i] = kr[i] = ak[i] = ww[i] = 0.f; }
      }
      ss = row16_sum(ss);
      if (valid) {
        const float inv = fminf(__builtin_amdgcn_rsqf(ss), 1e12f);
        float4 o0 = make_float4(rr[0], rr[1], rr[2], rr[3]), o1 = make_float4(kk[0], kk[1], kk[2], kk[3]), o2 = make_float4(ww[0], ww[1], ww[2], ww[3]);
        float4 o3 = make_float4(kr[0] * inv, kr[1] * inv, kr[2] * inv, kr[3] * inv);
        float4 o4 = make_float4(o3.x * ak[0], o3.y * ak[1], o3.z * ak[2], o3.w * ak[3]);
        *(float4*)(sq + st * 64 + sj * 4) = o0; *(float4*)(sk + st * 64 + sj * 4) = o1; *(float4*)(sg + st * 64 + sj * 4) = o2;
        *(float4*)(skk + st * 64 + sj * 4) = o3; *(float4*)(sak + st * 64 + sj * 4) = o4;
        sv[st * 16 + sj] = vv;
      }
    } else {
      if (valid) {
        const int i4 = (sj & 7) * 4;
        const float* rp = p.rope + (size_t)(pos0 + t) * 64;
        const float4 cs = *(const float4*)(rp + i4), sn = *(const float4*)(rp + 32 + i4);
        const float* cp = (const float*)&cs; const float* sp = (const float*)&sn;
        const float sc = sj < 8 ? 1.f : 0.125f;
        float* dst = sj < 8 ? sq : sk;
        float4 o1, o2; float* p1 = (float*)&o1; float* p2 = (float*)&o2;
#pragma unroll
        for (int i = 0; i < 4; ++i) {
          const float x1 = (float)r.a[i], x2 = (float)r.b[i];
          p1[i] = (x1 * cp[i] - x2 * sp[i]) * sc; p2[i] = (x1 * sp[i] + x2 * cp[i]) * sc;
        }
        *(float4*)(dst + st * 64 + i4) = o1; *(float4*)(dst + st * 64 + 32 + i4) = o2;
        sv[st * 16 + sj] = (float)r.v;
      }
    }
  };

  auto flush = [&](int tb, const char* buf) {
    const float* so = (const float*)buf + 5 * T * 64 + T * 16;
    const int t = tb + st;
    if (t < L) p.o[(size_t)(tok0 + t) * DM + MX * 256 + hd * 64 + vq * 16 + sj] = (h16)so[st * 16 + sj];
  };

  const int nbat = (L + T - 1) / T;
  Raw raw;
  __builtin_amdgcn_s_waitcnt(0x0F70);
  load_raw(0, raw);
  for (int bt = 0; bt < nbat; ++bt) {
    char* buf = smem + (bt & 1) * BUF;
    process(bt * T, raw, buf);
    __syncthreads();
    if (bt > 0) flush((bt - 1) * T, smem + ((bt - 1) & 1) * BUF);
    if (bt + 1 < nbat) load_raw((bt + 1) * T, raw);
    {
      const float* sq = (const float*)buf; const float* sk = sq + T * 64; const float* sg = sk + T * 64; const float* skk = sg + T * 64;
      const float* sak = skk + T * 64; const float* sv = sak + T * 64; float* so = (float*)sv + T * 16;
      const int nt = min(T, L - bt * T);
      constexpr int GS = (MX == 2) ? 2 : 4;
      for (int t0 = 0; t0 < nt; t0 += GS) {
        float vv[GS], part[GS];
#pragma unroll
        for (int u = 0; u < GS; ++u) vv[u] = sv[(t0 + u) * 16 + wave * 4 + vl];
        if constexpr (MX == 2) {
          f32x4 r4[GS], k4[GS], w4[GS], n4[GS], a4[GS];
#pragma unroll
          for (int u = 0; u < GS; ++u) {
            const int o_ = (t0 + u) * 64 + kg * 4;
            r4[u] = *(const f32x4*)(sq + o_); k4[u] = *(const f32x4*)(sk + o_); w4[u] = *(const f32x4*)(sg + o_);
            n4[u] = *(const f32x4*)(skk + o_); a4[u] = *(const f32x4*)(sak + o_);
          }
#pragma unroll
          for (int u = 0; u < GS; ++u) {
            const f32x2 d = n4[u].xy * SA + n4[u].zw * SB;
            const float ks = row16_sum(d.x + d.y);
            const f32x2 ta = k4[u].xy * vv[u] - a4[u].xy * ks, tb = k4[u].zw * vv[u] - a4[u].zw * ks;
            SA = w4[u].xy * SA + ta; SB = w4[u].zw * SB + tb;
            const f32x2 e = r4[u].xy * SA + r4[u].zw * SB;
            part[u] = e.x + e.y;
          }
        } else if constexpr (MX == 1) {
          f32x2 q2[GS], k2[GS], g2[GS];
#pragma unroll
          for (int u = 0; u < GS; ++u) {
            const int o_ = (t0 + u) * 64 + kg * 2;
            q2[u] = *(const f32x2*)(sq + o_); k2[u] = *(const f32x2*)(sk + o_); g2[u] = *(const f32x2*)(sg + o_);
          }
#pragma unroll
          for (int u = 0; u < GS; ++u) {
            SA = g2[u] * SA + k2[u] * vv[u];
            const f32x2 e = q2[u] * SA;
            part[u] = e.x + e.y;
          }
        } else {
          f32x4 q4[GS], k4[GS], g4[GS];
#pragma unroll
          for (int u = 0; u < GS; ++u) {
            const int o_ = (t0 + u) * 64 + kg * 4;
            q4[u] = *(const f32x4*)(sq + o_); k4[u] = *(const f32x4*)(sk + o_);
            if (MX == 0) g4[u] = *(const f32x4*)(sg + o_); else g4[u] = (f32x4){gam, gam, gam, gam};
          }
#pragma unroll
          for (int u = 0; u < GS; ++u) {
            SA = g4[u].xy * SA + k4[u].xy * vv[u]; SB = g4[u].zw * SB + k4[u].zw * vv[u];
            const f32x2 e = q4[u].xy * SA + q4[u].zw * SB;
            part[u] = e.x + e.y;
          }
        }
#pragma unroll
        for (int u = 0; u < GS; ++u) part[u] = row16_sum(part[u]);
        if (kg == 0) {
#pragma unroll
          for (int u = 0; u < GS; ++u) so[(t0 + u) * 16 + wave * 4 + vl] = part[u];
        }
      }
    }
  }
  __syncthreads();
  flush((nbat - 1) * T, smem + ((nbat - 1) & 1) * BUF);
  {
    float* dp;
    if (MX == 0) dp = p.out + (prompt ? O_PHG + ((size_t)(l * 8 + b) * 4 + hd) * 4096 : O_SHG + ((size_t)(l * 128 + b) * 4 + hd) * 4096);
    else if (MX == 1) dp = p.out + (prompt ? O_PGLA + ((size_t)(l * 8 + b) * 4 + hd) * 2048 : O_SGLA + ((size_t)(l * 128 + b) * 4 + hd) * 2048);
    else if (MX == 2) dp = p.out + (prompt ? O_PRW + ((size_t)(l * 8 + b) * 4 + hd) * 4096 : O_SRW + ((size_t)(l * 128 + b) * 4 + hd) * 4096);
    else dp = p.out + (prompt ? O_PRET + ((size_t)(l * 8 + b) * 4 + hd) * 4096 : O_SRET + ((size_t)(l * 128 + b) * 4 + hd) * 4096);
    S[0] = SA.x; S[1] = SA.y;
    if (KPL == 4) { S[KPL - 2] = SB.x; S[KPL - 1] = SB.y; }
#pragma unroll
    for (int i = 0; i < KPL; ++i) __builtin_nontemporal_store(S[i], dp + (kg * KPL + i) * 64 + vcol);
  }
  __syncthreads();
}


template <int MX> DEV void recur_sample(const Params& p, int l, int bp, int hd, char* smem) {
  constexpr int DK = (MX == 1) ? 32 : 64, KPL = DK / 16, T = 16;
  const int tid = tidx(), lane = tid & 63, wave = tid >> 6, vl = lane >> 4, kg = lane & 15;
  const int st = tid >> 4, sj = tid & 15;
  const int b_st = 2 * bp + (st >> 3), t = st & 7, tok = M_PROMPT + b_st * 8 + t;
  float* sq = (float*)smem; float* sk = sq + T * 64; float* sg = sk + T * 64; float* skk = sg + T * 64; float* sak = skk + T * 64;
  float* sv = sak + T * 64; float* so = sv + T * 64;
  const float* stin; float* stout;
  if (MX == 0) { stin = p.st_hg + ((size_t)(l * 128 + 2 * bp) * 4 + hd) * 4096; stout = p.out + O_SHG + ((size_t)(l * 128 + 2 * bp) * 4 + hd) * 4096; }
  else if (MX == 1) { stin = p.st_gla + ((size_t)(l * 128 + 2 * bp) * 4 + hd) * 2048; stout = p.out + O_SGLA + ((size_t)(l * 128 + 2 * bp) * 4 + hd) * 2048; }
  else if (MX == 2) { stin = p.st_rw + ((size_t)(l * 128 + 2 * bp) * 4 + hd) * 4096; stout = p.out + O_SRW + ((size_t)(l * 128 + 2 * bp) * 4 + hd) * 4096; }
  else { stin = p.st_ret + ((size_t)(l * 128 + 2 * bp) * 4 + hd) * 4096; stout = p.out + O_SRET + ((size_t)(l * 128 + 2 * bp) * 4 + hd) * 4096; }
  constexpr int SEQ_STRIDE = 4 * DK * 64;
  const int lofs = kg * KPL * 64 + wave * 4 + vl;
  float S[KPL], Sn[KPL];
#pragma unroll
  for (int i = 0; i < KPL; ++i) S[i] = __builtin_nontemporal_load(stin + lofs + i * 64);
  const float gam = 1.f - exp2f(-5.f - (float)hd);
  const h16* pr = p.P + (size_t)tok * NPC;
  if (MX == 0) {
    const h16x4 q4 = *(const h16x4*)(pr + C_HGQ + hd * 64 + sj * 4), f4 = *(const h16x4*)(pr + C_HGF + hd * 64 + sj * 4);
    const h16x4 v4 = *(const h16x4*)(pr + C_HGI + hd * 64 + sj * 4);
    float4 qo, ko, go; float* qp = (float*)&qo; float* kp = (float*)&ko; float* gp = (float*)&go;
#pragma unroll
    for (int i = 0; i < 4; ++i) {
      const int c = hd * 64 + sj * 4 + i;
      const float lb = l == 0 ? 0.f : 1.f / (1.f + __expf(p.hg_lb_logits[c] - p.hg_lb_logits[256 + c]));
      const float f = lb + (1.f - lb) * sigm((float)f4[i]);
      qp[i] = silu((float)q4[i]); kp[i] = 1.f - f; gp[i] = fmaxf(f, 1e-30f);
    }
    *(float4*)(sq + st * 64 + sj * 4) = qo; *(float4*)(sk + st * 64 + sj * 4) = ko; *(float4*)(sg + st * 64 + sj * 4) = go;
    *(float4*)(sv + st * 64 + sj * 4) = make_float4((float)v4[0], (float)v4[1], (float)v4[2], (float)v4[3]);
  } else if (MX == 1) {
    const h16x2 q2 = *(const h16x2*)(pr + C_GLQ + hd * 32 + sj * 2), k2 = *(const h16x2*)(pr + C_GLK + hd * 32 + sj * 2);
    const h16x8 g0 = *(const h16x8*)(pr + C_GLA), g1 = *(const h16x8*)(pr + C_GLA + 8);
    const h16x4 v4 = *(const h16x4*)(pr + C_GLV + hd * 64 + sj * 4);
#pragma unroll
    for (int i = 0; i < 2; ++i) {
      const int c = hd * 32 + sj * 2 + i;
      float z = p.gla_ba[l * 128 + c];
#pragma unroll
      for (int rr = 0; rr < 8; ++rr) z += (float)g0[rr] * p.gla_wa2[(size_t)l * 2048 + rr * 128 + c] + (float)g1[rr] * p.gla_wa2[(size_t)l * 2048 + (8 + rr) * 128 + c];
      const float ls = fminf(z, 0.f) - __logf(1.f + __expf(-fabsf(z)));
      sq[st * 64 + sj * 2 + i] = (float)q2[i] * 0.17677669529663687f;
      sk[st * 64 + sj * 2 + i] = (float)k2[i];
      sg[st * 64 + sj * 2 + i] = __expf(ls * 0.0625f);
    }
    *(float4*)(sv + st * 64 + sj * 4) = make_float4((float)v4[0], (float)v4[1], (float)v4[2], (float)v4[3]);
  } else if (MX == 2) {
    const h16x4 r4 = *(const h16x4*)(pr + C_RW + hd * 64 + sj * 4), k4 = *(const h16x4*)(pr + C_RW + 320 + hd * 64 + sj * 4);
    const h16x4 v4 = *(const h16x4*)(pr + C_RW + 576 + hd * 64 + sj * 4);
    const h16* rw = p.RWp + (size_t)tok * 512;
    const h16x4 w4 = *(const h16x4*)(rw + hd * 64 + sj * 4), a4 = *(const h16x4*)(rw + 256 + hd * 64 + sj * 4);
    float pc[4], pd[4], pv[4];
    if (t > 0) {
      const h16x4 c4 = *(const h16x4*)(pr - NPC + C_RW + hd * 64 + sj * 4), d4 = *(const h16x4*)(pr - NPC + C_RW + 320 + hd * 64 + sj * 4);
      const h16x4 e4 = *(const h16x4*)(pr - NPC + C_RW + 576 + hd * 64 + sj * 4);
#pragma unroll
      for (int i = 0; i < 4; ++i) { pc[i] = (float)c4[i]; pd[i] = (float)d4[i]; pv[i] = (float)e4[i]; }
    } else {
      const float* sh = p.st_shift + (size_t)(l * 128 + b_st) * 1024;
#pragma unroll
      for (int i = 0; i < 4; ++i) { pc[i] = sh[hd * 64 + sj * 4 + i]; pd[i] = sh[320 + hd * 64 + sj * 4 + i]; pv[i] = sh[576 + hd * 64 + sj * 4 + i]; }
    }
    float rr[4], kk[4], kr[4], ak[4], ww[4], vv[4], ss = 0.f;
#pragma unroll
    for (int i = 0; i < 4; ++i) {
      const int c = hd * 64 + sj * 4 + i;
      const float rc = (float)r4[i], kc = (float)k4[i], vc = (float)v4[i];
      rr[i] = rc + (pc[i] - rc) * p.rw_mu[l * 1024 + c];
      const float km = kc + (pd[i] - kc) * p.rw_mu[l * 1024 + 320 + c];
      vv[i] = vc + (pv[i] - vc) * p.rw_mu[l * 1024 + 576 + c];
      const float a = (float)a4[i];
      ww[i] = (float)w4[i];
      kk[i] = km * (1.f + (a - 1.f) * p.rw_ka[l * 256 + c]);
      kr[i] = km * p.rw_kk[l * 256 + c];
      ak[i] = a;
      ss += kr[i] * kr[i];
    }
    ss = row16_sum(ss);
    const float inv = fminf(__builtin_amdgcn_rsqf(ss), 1e12f);
    const float4 o3 = make_float4(kr[0] * inv, kr[1] * inv, kr[2] * inv, kr[3] * inv);
    *(float4*)(sq + st * 64 + sj * 4) = make_float4(rr[0], rr[1], rr[2], rr[3]);
    *(float4*)(sk + st * 64 + sj * 4) = make_float4(kk[0], kk[1], kk[2], kk[3]);
    *(float4*)(sg + st * 64 + sj * 4) = make_float4(ww[0], ww[1], ww[2], ww[3]);
    *(float4*)(skk + st * 64 + sj * 4) = o3;
    *(float4*)(sak + st * 64 + sj * 4) = make_float4(o3.x * ak[0], o3.y * ak[1], o3.z * ak[2], o3.w * ak[3]);
    *(float4*)(sv + st * 64 + sj * 4) = make_float4(vv[0], vv[1], vv[2], vv[3]);
  } else {
    const int base = sj < 8 ? C_RTQ : C_RTK, i4 = (sj & 7) * 4;
    const h16x4 x1 = *(const h16x4*)(pr + base + hd * 64 + i4), x2 = *(const h16x4*)(pr + base + hd * 64 + 32 + i4);
    const h16x4 v4 = *(const h16x4*)(pr + C_RTV + hd * 64 + sj * 4);
    const float* rp = p.rope + (size_t)(2048 + t) * 64;
    const float4 cs = *(const float4*)(rp + i4), sn = *(const float4*)(rp + 32 + i4);
    const float* cp = (const float*)&cs; const float* sp = (const float*)&sn;
    const float sc = sj < 8 ? 1.f : 0.125f;
    float* dst = sj < 8 ? sq : sk;
    float4 o1, o2; float* p1 = (float*)&o1; float* p2 = (float*)&o2;
#pragma unroll
    for (int i = 0; i < 4; ++i) {
      const float a = (float)x1[i], b2 = (float)x2[i];
      p1[i] = (a * cp[i] - b2 * sp[i]) * sc; p2[i] = (a * sp[i] + b2 * cp[i]) * sc;
    }
    *(float4*)(dst + st * 64 + i4) = o1; *(float4*)(dst + st * 64 + 32 + i4) = o2;
    *(float4*)(sv + st * 64 + sj * 4) = make_float4((float)v4[0], (float)v4[1], (float)v4[2], (float)v4[3]);
  }
  __builtin_amdgcn_s_waitcnt(0x0F70);
  __syncthreads();
#pragma nounroll
  for (int c = 0; c < 8; ++c) {
    const int seq = c >> 2, vq = c & 3, vcol = vq * 16 + wave * 4 + vl, rowb = seq * 8;
    if (c + 1 < 8) {
      const int o1_ = ((c + 1) >> 2) * SEQ_STRIDE + ((c + 1) & 3) * 16 + lofs;
#pragma unroll
      for (int i = 0; i < KPL; ++i) Sn[i] = __builtin_nontemporal_load(stin + o1_ + i * 64);
    }
    f32x2 SA = {S[0], S[1]}, SB = {S[KPL - 2], S[KPL - 1]};
    constexpr int GS = (MX == 2) ? 2 : 4;
#pragma nounroll
    for (int t0 = 0; t0 < 8; t0 += GS) {
      float vv[GS], part[GS];
#pragma unroll
      for (int u = 0; u < GS; ++u) vv[u] = sv[(rowb + t0 + u) * 64 + vcol];
      if constexpr (MX == 2) {
        f32x4 r4[GS], k4[GS], w4[GS], n4[GS], a4[GS];
#pragma unroll
        for (int u = 0; u < GS; ++u) {
          const int o_ = (rowb + t0 + u) * 64 + kg * 4;
          r4[u] = *(const f32x4*)(sq + o_); k4[u] = *(const f32x4*)(sk + o_); w4[u] = *(const f32x4*)(sg + o_);
          n4[u] = *(const f32x4*)(skk + o_); a4[u] = *(const f32x4*)(sak + o_);
        }
#pragma unroll
        for (int u = 0; u < GS; ++u) {
          const f32x2 d = n4[u].xy * SA + n4[u].zw * SB;
          const float ks = row16_sum(d.x + d.y);
          const f32x2 ta = k4[u].xy * vv[u] - a4[u].xy * ks, tb = k4[u].zw * vv[u] - a4[u].zw * ks;
          SA = w4[u].xy * SA + ta; SB = w4[u].zw * SB + tb;
          const f32x2 e = r4[u].xy * SA + r4[u].zw * SB;
          part[u] = e.x + e.y;
        }
      } else if constexpr (MX == 1) {
        f32x2 q2[GS], k2[GS], g2[GS];
#pragma unroll
        for (int u = 0; u < GS; ++u) {
          const int o_ = (rowb + t0 + u) * 64 + kg * 2;
          q2[u] = *(const f32x2*)(sq + o_); k2[u] = *(const f32x2*)(sk + o_); g2[u] = *(const f32x2*)(sg + o_);
        }
#pragma unroll
        for (int u = 0; u < GS; ++u) {
          SA = g2[u] * SA + k2[u] * vv[u];
          const f32x2 e = q2[u] * SA;
          part[u] = e.x + e.y;
        }
      } else {
        f32x4 q4[GS], k4[GS], g4[GS];
#pragma unroll
        for (int u = 0; u < GS; ++u) {
          const int o_ = (rowb + t0 + u) * 64 + kg * 4;
          q4[u] = *(const f32x4*)(sq + o_); k4[u] = *(const f32x4*)(sk + o_);
          if (MX == 0) g4[u] = *(const f32x4*)(sg + o_); else g4[u] = (f32x4){gam, gam, gam, gam};
        }
#pragma unroll
        for (int u = 0; u < GS; ++u) {
          SA = g4[u].xy * SA + k4[u].xy * vv[u]; SB = g4[u].zw * SB + k4[u].zw * vv[u];
          const f32x2 e = q4[u].xy * SA + q4[u].zw * SB;
          part[u] = e.x + e.y;
        }
      }
#pragma unroll
      for (int u = 0; u < GS; ++u) part[u] = row16_sum(part[u]);
      if (kg == 0) {
#pragma unroll
        for (int u = 0; u < GS; ++u) so[(rowb + t0 + u) * 64 + vcol] = part[u];
      }
    }
    {
      float* dp = stout + seq * SEQ_STRIDE + vq * 16 + lofs;
      __builtin_nontemporal_store(SA.x, dp); __builtin_nontemporal_store(SA.y, dp + 64);
      if (KPL == 4) { __builtin_nontemporal_store(SB.x, dp + 128); __builtin_nontemporal_store(SB.y, dp + 192); }
    }
#pragma unroll
    for (int i = 0; i < KPL; ++i) S[i] = Sn[i];
  }
  __syncthreads();
  {
    const float4 o = *(const float4*)(so + st * 64 + sj * 4);
    h16x4 oh = {(h16)o.x, (h16)o.y, (h16)o.z, (h16)o.w};
    *(h16x4*)(p.o + (size_t)tok * DM + MX * 256 + hd * 64 + sj * 4) = oh;
  }
  __syncthreads();
}


template <int MX> DEV void recur_wide(const Params& p, int l, int s, int hd, int vh, char* smem) {
  static_assert(MX != 2, "RWKV-7 needs the key reduction inside the step");
  constexpr int DK = (MX == 1) ? 32 : 64, KW = DK / 4, KL = KW / 2  , NP = KL / 2, T = 16;
  constexpr int IN_F = 4 * T * 64;
  constexpr int BUF = (IN_F + T * 4 * 64) * 4;
  const int tid = tidx(), lane = tid & 63, wave = tid >> 6, kh = lane >> 5, v32 = lane & 31;
  const int st = tid >> 4, sj = tid & 15;
  const int tok0 = s * 2048, L = 2048;
  const int krow0 = wave * KW + kh * KL;
  float c0[4] = {0.f, 0.f, 0.f, 0.f};
  float wa[2][16]; float ba[2] = {0.f, 0.f};
  if (MX == 0) {
#pragma unroll
    for (int i = 0; i < 4; ++i) { const int c = hd * 64 + sj * 4 + i; c0[i] = l == 0 ? 0.f : 1.f / (1.f + __expf(p.hg_lb_logits[c] - p.hg_lb_logits[256 + c])); }
  } else if (MX == 1) {
#pragma unroll
    for (int i = 0; i < 2; ++i) { const int c = hd * 32 + sj * 2 + i; ba[i] = p.gla_ba[l * 128 + c];
#pragma unroll
      for (int r = 0; r < 16; ++r) wa[i][r] = p.gla_wa2[(size_t)l * 2048 + r * 128 + c]; }
  }
  (void)wa; (void)ba; (void)c0;
  f32x2 S[NP];
#pragma unroll
  for (int j = 0; j < NP; ++j) S[j] = (f32x2){0.f, 0.f};
  const float gam = 1.f - exp2f(-5.f - (float)hd);

  auto load_raw = [&](int tb, Raw& r) {
    const h16* pr = p.P + (size_t)(tok0 + tb + st) * NPC;
    if (MX == 0) {
      r.a = *(const h16x4*)(pr + C_HGQ + hd * 64 + sj * 4); r.b = *(const h16x4*)(pr + C_HGF + hd * 64 + sj * 4);
      r.c = *(const h16x4*)(pr + C_HGI + hd * 64 + vh * 32 + (sj & 7) * 4);
    } else if (MX == 1) {
      const h16x2 q2 = *(const h16x2*)(pr + C_GLQ + hd * 32 + sj * 2), k2 = *(const h16x2*)(pr + C_GLK + hd * 32 + sj * 2);
      r.a[0] = q2[0]; r.a[1] = q2[1]; r.a[2] = k2[0]; r.a[3] = k2[1];
      r.g0 = *(const h16x8*)(pr + C_GLA); r.g1 = *(const h16x8*)(pr + C_GLA + 8);
      r.c = *(const h16x4*)(pr + C_GLV + hd * 64 + vh * 32 + (sj & 7) * 4);
    } else {
      const int base = sj < 8 ? C_RTQ : C_RTK, i4 = (sj & 7) * 4;
      r.a = *(const h16x4*)(pr + base + hd * 64 + i4); r.b = *(const h16x4*)(pr + base + hd * 64 + 32 + i4);
      r.c = *(const h16x4*)(pr + C_RTV + hd * 64 + vh * 32 + (sj & 7) * 4);
    }
  };
  auto process = [&](int tb, const Raw& r, char* buf) {
    float* sq = (float*)buf; float* sk = sq + T * 64; float* sg = sk + T * 64; float* sv = sg + T * 64;
    if (MX == 0) {
      float4 qo, ko, go; float* qp = (float*)&qo; float* kp = (float*)&ko; float* gp = (float*)&go;
#pragma unroll
      for (int i = 0; i < 4; ++i) {
        const float f = c0[i] + (1.f - c0[i]) * sigm((float)r.b[i]);
        qp[i] = silu((float)r.a[i]); kp[i] = 1.f - f; gp[i] = fmaxf(f, 1e-30f);
      }
      *(float4*)(sq + st * 64 + sj * 4) = qo; *(float4*)(sk + st * 64 + sj * 4) = ko; *(float4*)(sg + st * 64 + sj * 4) = go;
    } else if (MX == 1) {
#pragma unroll
      for (int i = 0; i < 2; ++i) {
        float z = ba[i];
#pragma unroll
        for (int rr = 0; rr < 8; ++rr) z += (float)r.g0[rr] * wa[i][rr] + (float)r.g1[rr] * wa[i][8 + rr];
        const float ls = fminf(z, 0.f) - __logf(1.f + __expf(-fabsf(z)));
        sq[st * 64 + sj * 2 + i] = (float)r.a[i] * 0.17677669529663687f;
        sk[st * 64 + sj * 2 + i] = (float)r.a[2 + i];
        sg[st * 64 + sj * 2 + i] = __expf(ls * 0.0625f);
      }
    } else {
      const int i4 = (sj & 7) * 4;
      const float* rp = p.rope + (size_t)(tb + st) * 64;
      const float4 cs = *(const float4*)(rp + i4), sn = *(const float4*)(rp + 32 + i4);
      const float* cp = (const float*)&cs; const float* sp = (const float*)&sn;
      const float sc = sj < 8 ? 1.f : 0.125f;
      float* dst = sj < 8 ? sq : sk;
      float4 o1, o2; float* p1 = (float*)&o1; float* p2 = (float*)&o2;
#pragma unroll
      for (int i = 0; i < 4; ++i) {
        const float x1 = (float)r.a[i], x2 = (float)r.b[i];
        p1[i] = (x1 * cp[i] - x2 * sp[i]) * sc; p2[i] = (x1 * sp[i] + x2 * cp[i]) * sc;
      }
      *(float4*)(dst + st * 64 + i4) = o1; *(float4*)(dst + st * 64 + 32 + i4) = o2;
    }
    if (sj < 8) *(float4*)(sv + st * 64 + sj * 4) = make_float4((float)r.c[0], (float)r.c[1], (float)r.c[2], (float)r.c[3]);
  };
  auto flush = [&](int tb, const char* buf) {
    if (sj >= 8) return;
    const float* sop = (const float*)buf + IN_F;
    float4 o = *(const float4*)(sop + (st * 8 + 0) * 32 + sj * 4);
#pragma unroll
    for (int w = 1; w < 8; ++w) { const float4 x = *(const float4*)(sop + (st * 8 + w) * 32 + sj * 4); o.x += x.x; o.y += x.y; o.z += x.z; o.w += x.w; }
    h16x4 oh = {(h16)o.x, (h16)o.y, (h16)o.z, (h16)o.w};
    *(h16x4*)(p.o + (size_t)(tok0 + tb + st) * DM + MX * 256 + hd * 64 + vh * 32 + sj * 4) = oh;
  };

  const int nbat = L / T;
  Raw raw;
  __builtin_amdgcn_s_waitcnt(0x0F70);
  load_raw(0, raw);
  for (int bt = 0; bt < nbat; ++bt) {
    char* buf = smem + (bt & 1) * BUF;
    process(bt * T, raw, buf);
    __syncthreads();
    if (bt > 0) flush((bt - 1) * T, smem + ((bt - 1) & 1) * BUF);
    if (bt + 1 < nbat) load_raw((bt + 1) * T, raw);
    {
      const float* sq = (const float*)buf; const float* sk = sq + T * 64; const float* sg = sk + T * 64; const float* sv = sg + T * 64;
      float* sop = (float*)buf + IN_F;
      constexpr int GS = 4, NC = KL / 4;
#pragma nounroll
      for (int t0 = 0; t0 < T; t0 += GS) {
        float vv[GS]; f32x4 q4[GS][NC], k4[GS][NC], g4[GS][NC];
#pragma unroll
        for (int u = 0; u < GS; ++u) {
          vv[u] = sv[(t0 + u) * 64 + v32];
#pragma unroll
          for (int j = 0; j < NC; ++j) {
            const int o_ = (t0 + u) * 64 + krow0 + j * 4;
            q4[u][j] = *(const f32x4*)(sq + o_); k4[u][j] = *(const f32x4*)(sk + o_);
            if (MX != 3) g4[u][j] = *(const f32x4*)(sg + o_); else g4[u][j] = (f32x4){gam, gam, gam, gam};
          }
        }
#pragma unroll
        for (int u = 0; u < GS; ++u) {
          f32x2 acc = {0.f, 0.f};
#pragma unroll
          for (int j = 0; j < NC; ++j) {
            S[2 * j] = g4[u][j].xy * S[2 * j] + k4[u][j].xy * vv[u];
            acc += q4[u][j].xy * S[2 * j];
            S[2 * j + 1] = g4[u][j].zw * S[2 * j + 1] + k4[u][j].zw * vv[u];
            acc += q4[u][j].zw * S[2 * j + 1];
          }
          sop[((t0 + u) * 8 + wave * 2 + kh) * 32 + v32] = acc.x + acc.y;
        }
      }
    }
  }
  __syncthreads();
  flush((nbat - 1) * T, smem + ((nbat - 1) & 1) * BUF);
  {
    float* dp;
    if (MX == 0) dp = p.out + O_PHG + ((size_t)(l * 8 + s) * 4 + hd) * 4096;
    else if (MX == 1) dp = p.out + O_PGLA + ((size_t)(l * 8 + s) * 4 + hd) * 2048;
    else dp = p.out + O_PRET + ((size_t)(l * 8 + s) * 4 + hd) * 4096;
#pragma unroll
    for (int j = 0; j < NP; ++j) { __builtin_nontemporal_store(S[j].x, dp + (krow0 + 2 * j) * 64 + vh * 32 + v32); __builtin_nontemporal_store(S[j].y, dp + (krow0 + 2 * j + 1) * 64 + vh * 32 + v32); }
  }
  __syncthreads();
}

DEV void recur_phase(const Params& p, int l, char* smem, int bid, int nb, int rep) {
  int* s_idx = (int*)(smem + 65536 + 16);
  const int total = 128 + 192 + 1024;
  for (;;) {
    if (tidx() == 0) *s_idx = (int)atomicAdd(p.ctr + l + 2 * rep, 1u);
    __syncthreads();
    const int idx = *s_idx;
    __syncthreads();
    if (idx >= total) break;
    if (idx < 128) {
      recur_item<2>(p, l, idx >> 4, (idx >> 2) & 3, idx & 3, smem);
    } else if (idx < 320) {
      const int r = idx - 128, mi = r >> 6, sq_ = (r >> 3) & 7, hd = (r >> 1) & 3, vh = r & 1;
      if (mi == 0) recur_wide<0>(p, l, sq_, hd, vh, smem);
      else if (mi == 1) recur_wide<1>(p, l, sq_, hd, vh, smem);
      else recur_wide<3>(p, l, sq_, hd, vh, smem);
    } else {
      const int r = idx - 320, mi = r >> 8, rem = r & 255, bp = rem >> 2, hd = rem & 3;
      if (mi == 0) recur_sample<2>(p, l, bp, hd, smem);
      else if (mi == 1) recur_sample<0>(p, l, bp, hd, smem);
      else if (mi == 2) recur_sample<1>(p, l, bp, hd, smem);
      else recur_sample<3>(p, l, bp, hd, smem);
    }
  }
}

DEV void post_phase(const Params& p, int l, char* smem, int bid, int nb) {
  h16* s_g16 = (h16*)smem;
  float* s_g = (float*)smem;
  const int tid = tidx(), j = tid;
  const float* mu = p.rw_mu + l * 1024;
  const float* g2 = p.rw_g2 + (size_t)l * 128 * 256;
  const float hgw = p.hg_norm_w[l * 64 + (j & 63)], glw = p.gla_norm_w[l * 64 + (j & 63)];
  const float lnw = p.rw_ln_w[l * 256 + j], lnb = p.rw_ln_b[l * 256 + j], rk = p.rw_rk[l * 256 + j], ka = p.rw_ka[l * 256 + j];
  const float mur = mu[j], muk = mu[320 + j], muv = mu[576 + j];
  for (int tile = bid; tile < M_TOK / 16; tile += nb) {
    const int tok0 = tile * 16;
    {
      const int tt = tid >> 4, c8 = (tid & 15) * 8, tok = tok0 + tt;
      int tpos, b;
      if (tok < M_PROMPT) { tpos = tok & 2047; b = -1; } else { tpos = (tok - M_PROMPT) & 7; b = (tok - M_PROMPT) >> 3; }
      const h16x8 cur = *(const h16x8*)(p.P + (size_t)tok * NPC + C_RW + 896 + c8);
      float pv[8];
      if (tpos > 0) { const h16x8 pr = *(const h16x8*)(p.P + (size_t)(tok - 1) * NPC + C_RW + 896 + c8);
#pragma unroll
        for (int i = 0; i < 8; ++i) pv[i] = (float)pr[i]; }
      else if (b >= 0) {
#pragma unroll
        for (int i = 0; i < 8; ++i) pv[i] = p.st_shift[(size_t)(l * 128 + b) * 1024 + 896 + c8 + i]; }
      else {
#pragma unroll
        for (int i = 0; i < 8; ++i) pv[i] = 0.f; }
      h16x8 sg8;
#pragma unroll
      for (int i = 0; i < 8; ++i) { const float c = (float)cur[i]; sg8[i] = (h16)sigm(c + (pv[i] - c) * mu[896 + c8 + i]); }
      *(h16x8*)(s_g16 + tt * 136 + c8) = sg8;
    }
    __syncthreads();
    float* s_ag = s_g + 16 * 128;
    {
      const int lane = tid & 63, wv = tid >> 6;
      h16x8 af[4];
#pragma unroll
      for (int ks = 0; ks < 4; ++ks) af[ks] = *(const h16x8*)(s_g16 + (lane & 15) * 136 + ks * 32 + (lane >> 4) * 8);
#pragma unroll
      for (int ct = 0; ct < 4; ++ct) {
        const h16* bp = p.lora + (size_t)((wv * 4 + ct) * 16 + (lane & 15)) * 128 + (lane >> 4) * 8;
        f32x4 c = {0.f, 0.f, 0.f, 0.f};
#pragma unroll
        for (int ks = 0; ks < 4; ++ks) c = __builtin_amdgcn_mfma_f32_16x16x32_f16(af[ks], *(const h16x8*)(bp + ks * 32), c, 0, 0, 0);
#pragma unroll
        for (int r = 0; r < 4; ++r) s_ag[((lane >> 4) * 4 + r) * 256 + (wv * 4 + ct) * 16 + (lane & 15)] = c[r];
      }
    }
    __syncthreads();
    for (int t0 = 0; t0 < 16; t0 += 8) {
      float o0[8], o1[8], o2[8], o3[8], g0[8], g1[8], g3[8], rc[8], kc[8], vc[8], rp[8], kp[8], vp[8], av[8];
#pragma unroll
      for (int u = 0; u < 8; ++u) {
        const int tok = tok0 + t0 + u;
        const h16* pr = p.P + (size_t)tok * NPC;
        const h16* op = p.o + (size_t)tok * DM;
        int tpos, b;
        if (tok < M_PROMPT) { tpos = tok & 2047; b = -1; } else { tpos = (tok - M_PROMPT) & 7; b = (tok - M_PROMPT) >> 3; }
        o0[u] = (float)op[j]; o1[u] = (float)op[256 + j]; o2[u] = (float)op[512 + j]; o3[u] = (float)op[768 + j];
        g0[u] = (float)pr[C_HGG + j]; g1[u] = (float)pr[C_GLG + j]; g3[u] = (float)pr[C_RTG + j];
        rc[u] = (float)pr[C_RW + j]; kc[u] = (float)pr[C_RW + 320 + j]; vc[u] = (float)pr[C_RW + 576 + j];
        av[u] = (float)p.RWp[(size_t)tok * 512 + 256 + j];
        const h16* pp = tpos > 0 ? pr - NPC : pr;
        rp[u] = (float)pp[C_RW + j]; kp[u] = (float)pp[C_RW + 320 + j]; vp[u] = (float)pp[C_RW + 576 + j];
        if (tpos == 0) {
          if (b >= 0) { const float* sh = p.st_shift + (size_t)(l * 128 + b) * 1024; rp[u] = sh[j]; kp[u] = sh[320 + j]; vp[u] = sh[576 + j]; }
          else { rp[u] = 0.f; kp[u] = 0.f; vp[u] = 0.f; }
        }
      }
#pragma unroll
      for (int u = 0; u < 8; ++u) {
        const int tok = tok0 + t0 + u;
        h16* op = p.o + (size_t)tok * DM;
        const float ms0 = wave_sum(o0[u] * o0[u]) * (1.f / 64.f);
        const float ms1 = wave_sum(o1[u] * o1[u]) * (1.f / 64.f);
        const float ms3 = wave_sum(o3[u] * o3[u]) * (1.f / 64.f);
        const float mean = wave_sum(o2[u]) * (1.f / 64.f);
        const float d = o2[u] - mean;
        const float var = wave_sum(d * d) * (1.f / 64.f);
        const float r = rc[u] + (rp[u] - rc[u]) * mur, km = kc[u] + (kp[u] - kc[u]) * muk, v = vc[u] + (vp[u] - vc[u]) * muv;
        const float k2 = km * (1.f + (av[u] - 1.f) * ka);
        const float bs = wave_sum(r * k2 * rk);
        op[j] = (h16)(o0[u] * rsqrtf(ms0 + 1e-6f) * hgw * silu(g0[u]));
        op[256 + j] = (h16)(o1[u] * rsqrtf(ms1 + 1e-6f) * glw * silu(g1[u]));
        op[512 + j] = (h16)((d * rsqrtf(var + 64e-5f) * lnw + lnb + bs * v) * s_ag[(t0 + u) * 256 + j]);
        op[768 + j] = (h16)(o3[u] * rsqrtf(ms3 + 1e-6f) * silu(g3[u]));
      }
    }
    __syncthreads();
  }
}

#define XB_TMO      128
#define XB_XCNT(j)  (256  + 64 * (j))
#define XB_XSUB(j)  (1280 + 64 * (j))
#define XB_XGEN(j)  (2304 + 64 * (j))
#define XB_TOP      3328
#define XB_TOPGEN   3392
#define XCD_BAR_WORDS 3456
#define XB_SPIN_CAP (1u << 20)
#define LAS __attribute__((address_space(3)))
DEV unsigned xb_ld(unsigned* p) { return __hip_atomic_load(p, __ATOMIC_RELAXED, __HIP_MEMORY_SCOPE_AGENT); }
DEV unsigned xb_add(unsigned* p, unsigned v) { return __hip_atomic_fetch_add(p, v, __ATOMIC_RELAXED, __HIP_MEMORY_SCOPE_AGENT); }
DEV unsigned xb_xcc_id() { return (unsigned)__builtin_amdgcn_s_getreg((3 << 11) | 20) & 0xFu; }
#define XB_SPIN(cond, bar) do { unsigned _sp = 0; while (cond) { __builtin_amdgcn_s_sleep(1); \
    if ((++_sp & 255u) == 0u) { if (xb_ld(&(bar)[XB_TMO])) break; if (_sp > XB_SPIN_CAP) { atomicAdd(&(bar)[XB_TMO], 1u); break; } } } } while (0)
struct XcdBarrier { unsigned* bar; unsigned x; volatile LAS unsigned* st; };
DEV XcdBarrier xcd_barrier_post(unsigned* bar, volatile LAS unsigned* st) {
  XcdBarrier b; b.bar = bar; b.x = xb_xcc_id(); b.st = st;
  if (threadIdx.x == 0) (void)xb_add(&bar[XB_XCNT(b.x)], 1u);
  return b;
}
DEV void xcd_barrier_complete(unsigned* bar, unsigned x, unsigned& nloc, unsigned& nx) {
  const unsigned G = gridDim.x * gridDim.y * gridDim.z;
  unsigned sum, cnt, mine, sp = 0u;
  for (;;) {
    sum = 0u; cnt = 0u; mine = 0u;
#pragma unroll
    for (unsigned j = 0; j < 16; ++j) { const unsigned c = xb_ld(&bar[XB_XCNT(j)]); sum += c; cnt += (c > 0u) ? 1u : 0u; mine = (j == x) ? c : mine; }
    if (sum == G) break;
    __builtin_amdgcn_s_sleep(1);
    if ((++sp & 255u) == 0u) { if (xb_ld(&bar[XB_TMO])) break; if (sp > XB_SPIN_CAP) { atomicAdd(&bar[XB_TMO], 1u); break; } }
  }
  nloc = mine > 0u ? mine : 1u; nx = cnt > 0u ? cnt : 1u;
}
DEV void xcd_barrier(const XcdBarrier& b) {
  asm volatile("s_waitcnt vmcnt(0)" ::: "memory");
  __syncthreads();
  if (threadIdx.x == 0) {
    unsigned* bar = b.bar;
    __builtin_amdgcn_s_waitcnt(0);
    unsigned nloc = b.st[0], nx = b.st[1];
    if (nloc == 0u) { xcd_barrier_complete(bar, b.x, nloc, nx); b.st[0] = nloc; b.st[1] = nx; }
    const unsigned old = xb_add(&bar[XB_XSUB(b.x)], 1u);
    const unsigned gen = old / nloc;
    if (old + 1u == (gen + 1u) * nloc) {
      __builtin_amdgcn_fence(__ATOMIC_RELEASE, "agent");
      asm volatile("s_waitcnt vmcnt(0)" ::: "memory");
      const unsigned og = xb_add(&bar[XB_TOP], 1u);
      const unsigned tg = og / nx;
      if (og + 1u == (tg + 1u) * nx) xb_add(&bar[XB_TOPGEN], 1u);
      else XB_SPIN(xb_ld(&bar[XB_TOPGEN]) == tg, bar);
      __builtin_amdgcn_fence(__ATOMIC_ACQUIRE, "agent");
      xb_add(&bar[XB_XGEN(b.x)], 1u);
      asm volatile("s_waitcnt vmcnt(0)" ::: "memory");
    } else {
      XB_SPIN(xb_ld(&bar[XB_XGEN(b.x)]) == gen, bar);
      __builtin_amdgcn_fence(__ATOMIC_ACQUIRE, "agent");
      asm volatile("s_waitcnt vmcnt(0)" ::: "memory");
    }
  }
  __syncthreads();
}

constexpr int N_PHASE = 24;
DEV void run_phase(const Params& p, int ph, char* smem, int bid, int nb) {
  if (ph == 0) { conv_phase(p, 0, smem, bid, nb); norm_phase<false>(p, 0, p.attn_norm_w, bid, nb); return; }
  if (ph == 23) { norm_phase<true>(p, 1, p.final_norm_w, bid, nb); return; }
  const int l = (ph - 1) / 11, s = (ph - 1) % 11;
  switch (s) {
    case 0: gemm1_phase(p, smem, bid, nb); break;
    case 1: prep_phase(p, l, smem, bid, nb); break;
    case 2:
#pragma nounroll
      for (int rep = 0; rep <= PROBE_RECUR; ++rep) recur_phase(p, l, smem, bid, nb, rep);
      break;
    case 3: post_phase(p, l, smem, bid, nb); break;
    case 4: gemmG_phase(p, smem, bid, nb); break;
    case 5: gemmU_phase(p, smem, bid, nb); break;
    case 6: gemm_res_phase<16>(p, l, l == 0, p.h, p.WT + WT_OUT, smem, bid, nb); break;
    case 7: norm_phase<false>(p, 1, p.ffn_norm_w + l * DM, bid, nb); break;
    case 8: gemm4_phase(p, smem, bid, nb); break;
    case 9: gemm_res_phase<44>(p, 1, false, p.P, p.WT + WT_FOUT, smem, bid, nb); break;
    default:
      if (l == 0) { conv_phase(p, 1, smem, bid, nb); norm_phase<false>(p, 1, p.attn_norm_w + DM, bid, nb); }
      break;
  }
}

constexpr int SMEM_BYTES = 65536 + 64;
extern __shared__ __attribute__((aligned(16))) char smem[];
#if !MEGA
__global__ void __launch_bounds__(256, 2) k_single(Params p, int ph) {
  run_phase(p, ph, smem, blockIdx.x, gridDim.x);
}

#else
__global__ void __launch_bounds__(256, 2) k_mega(Params p) {
  cg::grid_group grid = cg::this_grid();
  volatile LAS unsigned* st = (volatile LAS unsigned*)(smem + 65536);
  if (threadIdx.x == 0) { st[0] = 0u; st[1] = 0u; }
  __syncthreads();
  const XcdBarrier xb = xcd_barrier_post(p.bar, st);
  if (p.out == nullptr) grid.sync();
#define PH(n) run_phase(p, n, smem, blockIdx.x, gridDim.x); xcd_barrier(xb); \
  if ((n) >= 1 && (n) <= 22 && ((PROBE_DUP >> (((n) - 1) % 11)) & 1)) { \
    run_phase(p, n, smem, blockIdx.x, gridDim.x); \
    xcd_barrier(xb); }
  PH(0) PH(1) PH(2) PH(3) PH(4) PH(5) PH(6) PH(7) PH(8) PH(9) PH(10) PH(11)
  PH(12) PH(13) PH(14) PH(15) PH(16) PH(17) PH(18) PH(19) PH(20) PH(21)
  run_phase(p, 23, smem, blockIdx.x, gridDim.x);
#undef PH
}
#endif

extern "C" void kernel_launch(void* const* d_in, const int* in_sizes, int n_in, void* d_out, int out_size, void* d_ws, size_t ws_size,
                              hipStream_t stream) {
  (void)in_sizes; (void)n_in; (void)out_size;
  if (ws_size < WS_END) { fprintf(stderr, "workspace too small: %zu < %zu\n", ws_size, (size_t)WS_END); return; }
  Params p{};
  const float** f = (const float**)&p;
  for (int i = 0; i < 31; ++i) f[i] = (const float*)d_in[i];
  p.out = (float*)d_out;
  char* ws = (char*)d_ws;
  p.WT = (h16*)(ws + WS_WT); p.h = (h16*)(ws + WS_H); p.o = (h16*)(ws + WS_O); p.P = (h16*)(ws + WS_P); p.RWp = (h16*)(ws + WS_RWP);
  p.rope = (float*)(ws + WS_ROPE); p.ctr = (unsigned*)(ws + WS_CTR); p.bar = (unsigned*)(ws + WS_BAR); p.lora = (h16*)(ws + WS_LORA);
  static int grid_blocks = 0;
  if (!grid_blocks) {
    int dev = 0, cus = 0, per_cu = 0;
    (void)hipGetDevice(&dev);
    (void)hipDeviceGetAttribute(&cus, hipDeviceAttributeMultiprocessorCount, dev);
#if MEGA
    (void)hipFuncSetAttribute((const void*)k_mega, hipFuncAttributeMaxDynamicSharedMemorySize, SMEM_BYTES);
    (void)hipOccupancyMaxActiveBlocksPerMultiprocessor(&per_cu, k_mega, 256, SMEM_BYTES);
#else
    (void)hipFuncSetAttribute((const void*)k_single, hipFuncAttributeMaxDynamicSharedMemorySize, SMEM_BYTES);
    (void)hipOccupancyMaxActiveBlocksPerMultiprocessor(&per_cu, k_single, 256, SMEM_BYTES);
#endif
    if (per_cu < 1) per_cu = 1;
    if (per_cu > 2) per_cu = 2;
    grid_blocks = cus * per_cu;
  }
  (void)hipMemsetAsync(p.ctr, 0, 256 + 3456 * 4, stream);
#if MEGA
  void* args[] = {&p};
  hipError_t e = hipLaunchCooperativeKernel((void*)k_mega, dim3(grid_blocks), dim3(256), args, SMEM_BYTES, stream);
  if (e != hipSuccess) fprintf(stderr, "cooperative launch failed: %s (grid %d)\n", hipGetErrorString(e), grid_blocks);
#else
  for (int ph = 0; ph < N_PHASE; ++ph) {
    if (ph == 22) continue;
    k_single<<<grid_blocks, 256, SMEM_BYTES, stream>>>(p, ph);
  }
#endif
}
```

```cpp
#include <hip/hip_runtime.h>
#include <hip/hip_cooperative_groups.h>
#include <cstdio>
namespace cg = cooperative_groups;

#ifndef MEGA
#define MEGA 1
#endif
#define PROBE_RECUR 0
#define PROBE_DUP 0

typedef _Float16 h16;
typedef _Float16 h16x8 __attribute__((ext_vector_type(8)));
typedef _Float16 h16x4 __attribute__((ext_vector_type(4)));
typedef _Float16 h16x2 __attribute__((ext_vector_type(2)));
typedef float f32x4 __attribute__((ext_vector_type(4)));
typedef unsigned u32x4 __attribute__((ext_vector_type(4)));
typedef float f32x2 __attribute__((ext_vector_type(2)));
#define DEV __device__ __forceinline__

constexpr int M_TOK = 17408, M_PROMPT = 16384, DM = 1024, NPC = 3856  , DFF = 2816;
constexpr int C_HGQ = 0, C_HGF = 256, C_HGI = 512, C_HGG = 768;
constexpr int C_GLQ = 1024, C_GLK = 1152, C_GLV = 1280, C_GLG = 1536, C_GLA = 3840;
constexpr int C_RW = 1792;
constexpr int C_RTQ = 2816, C_RTK = 3072, C_RTV = 3328, C_RTG = 3584;
constexpr size_t WT_IN = 0, WT_G = 4063232, WT_BR = 8257536, WT_OUT = 9306112, WT_FIN = 10354688, WT_FOUT = 16121856,
                 WT_TOTAL = 19005440;
constexpr size_t WS_WT = 0, WS_H = WS_WT + WT_TOTAL * 2, WS_O = WS_H + (size_t)M_TOK * DM * 2, WS_P = WS_O + (size_t)M_TOK * DM * 2,
                 WS_RWP = WS_P + (size_t)M_TOK * NPC * 2, WS_ROPE = WS_RWP + (size_t)M_TOK * 512 * 2,
                 WS_CTR = WS_ROPE + (size_t)2056 * 64 * 4, WS_BAR = WS_CTR + 256, WS_LORA = WS_BAR + 3456 * 4 + 256, WS_END = WS_LORA + (size_t)(256 * 128 + 2 * 256 * 64) * 2;
constexpr size_t O_PHG = 17825792, O_PGLA = 18087936, O_PRW = 18219008, O_PSH = 18481152, O_PRET = 18497536, O_SHG = 18759680,
                 O_SGLA = 22953984, O_SRW = 25051136, O_SSH = 29245440, O_SRET = 29507584;

struct Params {
  const float *x_prompt, *x_sample, *st_hg, *st_gla, *st_rw, *st_shift, *st_ret;
  const float *attn_norm_w, *w_in, *hg_lb_logits, *hg_norm_w, *gla_wa2, *gla_ba, *gla_norm_w;
  const float *rw_mu, *rw_w0, *rw_w2, *rw_a0, *rw_a2, *rw_g2, *rw_kk, *rw_ka, *rw_rk, *rw_ln_w, *rw_ln_b;
  const float *w_branch, *w_out, *ffn_norm_w, *w_ffn_in, *w_ffn_out, *final_norm_w;
  float* out;
  h16 *WT, *h, *o, *P, *RWp;
  float* rope;
  unsigned* ctr;
  unsigned* bar;
  h16* lora;
};

DEV int tidx() { int t = threadIdx.x; asm volatile("" : "+v"(t)); return t; }
DEV float sigm(float x) { return __builtin_amdgcn_rcpf(1.f + __expf(-x)); }
DEV float silu(float x) { return x * sigm(x); }
template <int CTRL> DEV float dpp_f(float x) {
  return __int_as_float(__builtin_amdgcn_update_dpp(0, __float_as_int(x), CTRL, 0xf, 0xf, false));
}
DEV float row16_sum(float x) {
  x += dpp_f<0x128>(x); x += dpp_f<0x124>(x); x += dpp_f<0x122>(x); x += dpp_f<0x121>(x);
  return x;
}
DEV float wave_sum(float x) {
  x = row16_sum(x);
  x += __shfl_xor(x, 16);
  x += __shfl_xor(x, 32);
  return x;
}
DEV const float* xrow_in(const Params& p, int l, int row) {
  if (l > 0) return p.out + (size_t)row * DM;
  return row < M_PROMPT ? p.x_prompt + (size_t)row * DM : p.x_sample + (size_t)(row - M_PROMPT) * DM;
}

DEV void conv_phase(const Params& p, int l, char* smem_raw, int bid, int nb) {
  h16* lds = (h16*)smem_raw;
  const int tid = tidx();
  for (int e = bid * 256 + tid; e < 256 * 16 + 2 * 256 * 8; e += nb * 256) {
    const float* src; h16* dst; int K, col, k8;
    if (e < 256 * 16) { src = p.rw_g2 + (size_t)l * 128 * 256; dst = p.lora; K = 128; col = e >> 4; k8 = (e & 15) * 8; }
    else { const int r = e - 256 * 16, mtx = r >> 11, q = r & 2047; src = (mtx ? p.rw_a2 : p.rw_w2) + (size_t)l * 64 * 256; dst = p.lora + 256 * 128 + mtx * 256 * 64; K = 64; col = q >> 3; k8 = (q & 7) * 8; }
    h16x8 o;
#pragma unroll
    for (int i = 0; i < 8; ++i) o[i] = (h16)src[(size_t)(k8 + i) * 256 + col];
    *(h16x8*)(dst + (size_t)col * K + k8) = o;
  }
  constexpr int NT0 = 62 * 16, NT1 = 64 * 16, NT2 = 16 * 16, NT3 = 16 * 16, NT4 = 88 * 16, NT5 = 16 * 44;
  constexpr int total = NT0 + NT1 + NT2 + NT3 + NT4 + NT5;
  for (int id = bid; id < total; id += nb) {
    int job = 0, r = id;
    if (r >= NT0) { r -= NT0; job = 1;
      if (r >= NT1) { r -= NT1; job = 2;
        if (r >= NT2) { r -= NT2; job = 3;
          if (r >= NT3) { r -= NT3; job = 4;
            if (r >= NT4) { r -= NT4; job = 5; } } } } }
    int K, ld; const float* src; h16* dst;
    switch (job) {
      case 0: K = 1024; ld = 7952; src = p.w_in + (size_t)l * 1024 * 7952; dst = p.WT + WT_IN; break;
      case 1: K = 1024; ld = 7952; src = p.w_in + (size_t)l * 1024 * 7952; dst = p.WT + WT_G; break;
      case 2: K = 1024; ld = 1024; src = p.w_branch + (size_t)l * 4 * 256 * 1024; dst = p.WT + WT_BR; break;
      case 3: K = 1024; ld = 1024; src = p.w_out + (size_t)l * 1024 * 1024; dst = p.WT + WT_OUT; break;
      case 4: K = 1024; ld = 5632; src = p.w_ffn_in + (size_t)l * 1024 * 5632; dst = p.WT + WT_FIN; break;
      default: K = 2816; ld = 1024; src = p.w_ffn_out + (size_t)l * 2816 * 1024; dst = p.WT + WT_FOUT; break;
    }
    const int nkt = K / 64, nt_ = r / nkt, kt = r % nkt, n0 = nt_ * 64, k0 = kt * 64;
    {
      const int n4 = (tid & 15) * 4, kk = tid >> 4;
      const int n16 = n0 + (n4 & ~15);
      int col; const float* s = src;
      switch (job) {
        case 0: col = n16 < 1536 ? n16 : (n16 < 3840 ? n16 + 16 : (n16 == 3840 ? 1536 : -1)); break;
        case 1: col = 3856 + n16; break;
        case 4: { int tile = n16 >> 7, wc = (n16 >> 6) & 1, sub = (n16 >> 4) & 3; col = (sub >> 1) * DFF + tile * 64 + wc * 32 + (sub & 1) * 16; } break;
        default: col = n16; break;
      }
#pragma unroll
      for (int i = 0; i < 4; ++i) {
        const int k = kk + 16 * i;
        float4 v = make_float4(0.f, 0.f, 0.f, 0.f);
        if (col >= 0) { const f32x4 t_ = __builtin_nontemporal_load((const f32x4*)(s + (size_t)(k0 + k) * ld + col + (n4 & 15))); v = make_float4(t_[0], t_[1], t_[2], t_[3]); }
        lds[(n4 + 0) * 72 + k] = (h16)v.x; lds[(n4 + 1) * 72 + k] = (h16)v.y;
        lds[(n4 + 2) * 72 + k] = (h16)v.z; lds[(n4 + 3) * 72 + k] = (h16)v.w;
      }
    }
    __syncthreads();
    {
      const int n = tid >> 2, kc = (tid & 3) * 16;
      const uint4 a = *(const uint4*)(lds + n * 72 + kc), b = *(const uint4*)(lds + n * 72 + kc + 8);
      uint4* d = (uint4*)(dst + (size_t)(n0 + n) * K + k0 + kc);
      d[0] = a; d[1] = b;
    }
    __syncthreads();
  }
}

template <bool FINAL> DEV void norm_phase(const Params& p, int l, const float* w, int bid, int nb) {
  const int lane = tidx() & 63, wv = tidx() >> 6;
  for (int row0 = bid * 4 + wv; row0 < M_TOK; row0 += nb * 8) {
    const int row1 = row0 + nb * 4;
    const bool has1 = row1 < M_TOK;
    const float* xr0 = FINAL ? p.out + (size_t)row0 * DM : xrow_in(p, l, row0);
    const float* xr1 = has1 ? (FINAL ? p.out + (size_t)row1 * DM : xrow_in(p, l, row1)) : xr0;
    float4 v0[4], v1[4], ww[4]; float s0 = 0.f, s1 = 0.f;
#pragma unroll
    for (int i = 0; i < 4; ++i) {
      if (!FINAL && l == 0) {
        const f32x4 t0 = __builtin_nontemporal_load((const f32x4*)(xr0 + i * 256 + lane * 4)), t1 = __builtin_nontemporal_load((const f32x4*)(xr1 + i * 256 + lane * 4));
        v0[i] = make_float4(t0[0], t0[1], t0[2], t0[3]); v1[i] = make_float4(t1[0], t1[1], t1[2], t1[3]);
      } else { v0[i] = *(const float4*)(xr0 + i * 256 + lane * 4); v1[i] = *(const float4*)(xr1 + i * 256 + lane * 4); }
      ww[i] = *(const float4*)(w + i * 256 + lane * 4);
    }
#pragma unroll
    for (int i = 0; i < 4; ++i) {
      s0 += v0[i].x * v0[i].x + v0[i].y * v0[i].y + v0[i].z * v0[i].z + v0[i].w * v0[i].w;
      s1 += v1[i].x * v1[i].x + v1[i].y * v1[i].y + v1[i].z * v1[i].z + v1[i].w * v1[i].w;
    }
    s0 = wave_sum(s0); s1 = wave_sum(s1);
    const float r0 = rsqrtf(s0 * (1.f / 1024.f) + 1e-6f), r1 = rsqrtf(s1 * (1.f / 1024.f) + 1e-6f);
#pragma unroll
    for (int i = 0; i < 4; ++i) {
      {
        const float a = v0[i].x * r0 * ww[i].x, b = v0[i].y * r0 * ww[i].y, c = v0[i].z * r0 * ww[i].z, d = v0[i].w * r0 * ww[i].w;
        if (FINAL) *(float4*)(p.out + (size_t)row0 * DM + i * 256 + lane * 4) = make_float4(a, b, c, d);
        else { h16x4 o = {(h16)a, (h16)b, (h16)c, (h16)d}; *(h16x4*)(p.h + (size_t)row0 * DM + i * 256 + lane * 4) = o; }
      }
      if (has1) {
        const float a = v1[i].x * r1 * ww[i].x, b = v1[i].y * r1 * ww[i].y, c = v1[i].z * r1 * ww[i].z, d = v1[i].w * r1 * ww[i].w;
        if (FINAL) *(float4*)(p.out + (size_t)row1 * DM + i * 256 + lane * 4) = make_float4(a, b, c, d);
        else { h16x4 o = {(h16)a, (h16)b, (h16)c, (h16)d}; *(h16x4*)(p.h + (size_t)row1 * DM + i * 256 + lane * 4) = o; }
      }
    }
  }
}

struct NoHook { DEV void prefetch(int) {} DEV void apply(int) {} };
template <int WN, int LDA, int LDB, int NK, int PF = 2, int HOOK = 0, class HookT = NoHook>
DEV void gemm_kloop(const h16* __restrict__ Ag, const h16* __restrict__ Bg, f32x4 (&acc)[4][WN], char* smem, HookT hook = HookT()) {
  static_assert(NK % 2 == 0, "NK must be even");
  constexpr int BN = 32 * WN, BCH = BN / 32, STG = (128 + BN) * 128;
  const int tid = tidx(), lane = tid & 63, wave = tid >> 6, wr = wave >> 1, wc = wave & 1;
  const int r0 = tid >> 3, c0 = tid & 7;
  const char* Ab = (const char*)Ag;
  const char* Bb = (const char*)Bg;
  const unsigned aofs = (unsigned)(r0 * LDA + c0 * 8) * 2u, bofs = (unsigned)(r0 * LDB + c0 * 8) * 2u;
  const int wofs = r0 * 128 + ((c0 ^ ((r0 >> 1) & 7)) << 4);
  u32x4 ra0[4], rb0[BCH], ra1[4], rb1[BCH];
  const int sw = (lane >> 1) & 7, q = lane >> 4;
  const int fo0 = (lane & 15) * 128 + (((q) ^ sw) << 4), fo1 = (lane & 15) * 128 + (((4 + q) ^ sw) << 4);
  const int aoff = wr * 64 * 128, boff = 128 * 128 + wc * (16 * WN) * 128;

  auto g_load = [&](u32x4 (&RA)[4], u32x4 (&RB)[BCH], int kt) {
#pragma unroll
    for (int i = 0; i < 4; ++i) RA[i] = *(const u32x4*)(Ab + (size_t)kt * 128 + (aofs + (unsigned)(i * 32 * LDA * 2)));
#pragma unroll
    for (int i = 0; i < BCH; ++i) RB[i] = *(const u32x4*)(Bb + (size_t)kt * 128 + (bofs + (unsigned)(i * 32 * LDB * 2)));
  };
  auto s_store = [&](const u32x4 (&RA)[4], const u32x4 (&RB)[BCH], int buf) {
    char* s_ = smem + buf * STG;
#pragma unroll
    for (int i = 0; i < 4; ++i) *(u32x4*)(s_ + wofs + i * 4096) = RA[i];
#pragma unroll
    for (int i = 0; i < BCH; ++i) *(u32x4*)(s_ + 16384 + wofs + i * 4096) = RB[i];
  };
  auto compute = [&](int buf) {
    const char* s_ = smem + buf * STG;
    if constexpr (HOOK != 0) {
#pragma unroll
      for (int ks = 0; ks < 2; ++ks) {
        const int fo = ks ? fo1 : fo0;
        h16x8 af[4], bf[WN];
#pragma unroll
        for (int m = 0; m < 4; ++m) af[m] = *(const h16x8*)(s_ + aoff + m * 2048 + fo);
#pragma unroll
        for (int n = 0; n < WN; ++n) bf[n] = *(const h16x8*)(s_ + boff + n * 2048 + fo);
        __builtin_amdgcn_sched_barrier(0);
#pragma unroll
        for (int m = 0; m < 4; ++m)
#pragma unroll
          for (int n = 0; n < WN; ++n) acc[m][n] = __builtin_amdgcn_mfma_f32_16x16x32_f16(bf[n], af[m], acc[m][n], 0, 0, 0);
        __builtin_amdgcn_sched_barrier(0);
      }
    } else {
    h16x8 af[2][4], bf[2][WN];
#pragma unroll
    for (int ks = 0; ks < 2; ++ks) {
      const int fo = ks ? fo1 : fo0;
#pragma unroll
      for (int m = 0; m < 4; ++m) af[ks][m] = *(const h16x8*)(s_ + aoff + m * 2048 + fo);
#pragma unroll
      for (int n = 0; n < WN; ++n) bf[ks][n] = *(const h16x8*)(s_ + boff + n * 2048 + fo);
    }
    __builtin_amdgcn_sched_barrier(0);
#pragma unroll
    for (int ks = 0; ks < 2; ++ks)
#pragma unroll
      for (int m = 0; m < 4; ++m)
#pragma unroll
        for (int n = 0; n < WN; ++n) acc[m][n] = __builtin_amdgcn_mfma_f32_16x16x32_f16(bf[ks][n], af[ks][m], acc[m][n], 0, 0, 0);
    __builtin_amdgcn_sched_barrier(0);
    }
  };
  if constexpr (PF == 3) {
    const unsigned c0s = (unsigned)(c0 ^ ((r0 >> 1) & 7));
    const unsigned aofd = (unsigned)(r0 * LDA) * 2u + c0s * 16u, bofd = (unsigned)(r0 * LDB) * 2u + c0s * 16u;
    auto dma = [&](int kt, int buf) {
      char* s_ = smem + buf * STG + tid * 16;
#pragma unroll
      for (int i = 0; i < 4; ++i)
        __builtin_amdgcn_global_load_lds((const unsigned*)(Ab + (size_t)kt * 128 + (aofd + (unsigned)(i * 32 * LDA * 2))), (unsigned*)(s_ + i * 4096), 16, 0, 0);
#pragma unroll
      for (int i = 0; i < BCH; ++i)
        __builtin_amdgcn_global_load_lds((const unsigned*)(Bb + (size_t)kt * 128 + (bofd + (unsigned)(i * 32 * LDB * 2))), (unsigned*)(s_ + 16384 + i * 4096), 16, 0, 0);
    };
    dma(0, 0);
#pragma nounroll
    for (int kt = 0; kt < NK; kt += 2) {
      asm volatile("s_waitcnt vmcnt(0)" ::: "memory");
      __syncthreads();
      dma(kt + 1, 1);
      if (HOOK && (kt & 3) == 0) hook.prefetch(kt >> 2);
      compute(0);
      asm volatile("s_waitcnt vmcnt(0)" ::: "memory");
      __syncthreads();
      if (kt + 2 < NK) dma(kt + 2, 0);
      compute(1);
      if (HOOK && (kt & 3) == 2) hook.apply(kt >> 2);
    }
    __syncthreads();
  } else if constexpr (PF == 2) {
    g_load(ra0, rb0, 0);
    g_load(ra1, rb1, 1);
    s_store(ra0, rb0, 0);
    __syncthreads();
#pragma nounroll
    for (int kt = 0; kt < NK; kt += 2) {
      if (kt + 2 < NK) g_load(ra0, rb0, kt + 2);
      if (HOOK && (kt & 3) == 0) hook.prefetch(kt >> 2);
      compute(0);
      s_store(ra1, rb1, 1);
      __syncthreads();
      if (kt + 3 < NK) g_load(ra1, rb1, kt + 3);
      compute(1);
      if (kt + 2 < NK) s_store(ra0, rb0, 0);
      if (HOOK && (kt & 3) == 2) hook.apply(kt >> 2);
      __syncthreads();
    }
  } else {
    g_load(ra0, rb0, 0);
    s_store(ra0, rb0, 0);
    __syncthreads();
#pragma nounroll
    for (int kt = 0; kt < NK; kt += 2) {
      g_load(ra0, rb0, kt + 1);
      compute(0);
      s_store(ra0, rb0, 1);
      __syncthreads();
      if (kt + 2 < NK) g_load(ra0, rb0, kt + 2);
      compute(1);
      if (kt + 2 < NK) s_store(ra0, rb0, 0);
      __syncthreads();
    }
  }
}

template <int NTM, int NTN, class F> DEV void for_tiles_xcd(int bid, int nb, F f) {
  static_assert(NTM % 8 == 0, "row panels must split evenly over 8 XCDs");
  if ((nb & 7) != 0) { for (int id = bid; id < NTM * NTN; id += nb) f(id % NTM, id / NTM); return; }
  constexpr int PM = NTM / 8;
  const int xcd = bid & 7, nloc = nb >> 3;
  for (int i = bid >> 3; i < PM * NTN; i += nloc) {
    const int tn = i / PM, pm = i - tn * PM;
    f(pm * 8 + xcd, tn);
  }
}
DEV void tile_coords(int id, int NT, int& tm, int& tn) { const int per = 8 * NT, g = id / per, r = id - g * per; tm = g * 8 + (r & 7); tn = r >> 3; }

DEV void gemm1_phase(const Params& p, char* smem, int bid, int nb) {
  const int lane = tidx() & 63, wave = tidx() >> 6, wr = wave >> 1, wc = wave & 1;
  for_tiles_xcd<136, 30>(bid, nb, [&](int tm, int tn) {
    f32x4 acc[4][4];
#pragma unroll
    for (int m = 0; m < 4; ++m)
#pragma unroll
      for (int n = 0; n < 4; ++n) acc[m][n] = (f32x4){0.f, 0.f, 0.f, 0.f};
    gemm_kloop<4, DM, 1024, 16, 3>(p.h + (size_t)tm * 128 * DM, p.WT + WT_IN + (size_t)tn * 128 * 1024, acc, smem);
#pragma unroll
    for (int m = 0; m < 4; ++m) {
      const int row = tm * 128 + wr * 64 + m * 16 + (lane & 15);
#pragma unroll
      for (int n = 0; n < 4; ++n) {
        const int col = tn * 128 + wc * 64 + n * 16 + (lane >> 4) * 4;
        { h16x4 o = {(h16)acc[m][n][0], (h16)acc[m][n][1], (h16)acc[m][n][2], (h16)acc[m][n][3]}; *(h16x4*)(p.P + (size_t)row * NPC + col) = o; }
      }
    }
  });
}

DEV void gemmG_phase(const Params& p, char* smem, int bid, int nb) {
  const int lane = tidx() & 63, wave = tidx() >> 6, wr = wave >> 1, wc = wave & 1;
  h16* G = p.P;
  for_tiles_xcd<136, 32>(bid, nb, [&](int tm, int tn) {
    f32x4 acc[4][4];
#pragma unroll
    for (int m = 0; m < 4; ++m)
#pragma unroll
      for (int n = 0; n < 4; ++n) acc[m][n] = (f32x4){0.f, 0.f, 0.f, 0.f};
    gemm_kloop<4, DM, 1024, 16, 3>(p.h + (size_t)tm * 128 * DM, p.WT + WT_G + (size_t)tn * 128 * 1024, acc, smem);
#pragma unroll
    for (int m = 0; m < 4; ++m) {
      const int row = tm * 128 + wr * 64 + m * 16 + (lane & 15);
#pragma unroll
      for (int n = 0; n < 4; ++n) {
        const int col = tn * 128 + wc * 64 + n * 16 + (lane >> 4) * 4;
        h16x4 o = {(h16)sigm(acc[m][n][0]), (h16)sigm(acc[m][n][1]), (h16)sigm(acc[m][n][2]), (h16)sigm(acc[m][n][3])};
        *(h16x4*)(G + (size_t)row * 4096 + col) = o;
      }
    }
  });
}

struct MergeHook {
  f32x4 (&acc)[4][2]; f32x4 (&mg)[4][2]; h16x4 (&gt)[4][2]; const h16* gp;
  DEV void prefetch(int b) {
#pragma unroll
    for (int m = 0; m < 4; ++m)
#pragma unroll
      for (int n = 0; n < 2; ++n) gt[m][n] = *(const h16x4*)(gp + (size_t)m * 16 * 4096 + b * 1024 + n * 16);
  }
  DEV void apply(int) {
#pragma unroll
    for (int m = 0; m < 4; ++m)
#pragma unroll
      for (int n = 0; n < 2; ++n) {
#pragma unroll
        for (int j = 0; j < 4; ++j) mg[m][n][j] += (float)gt[m][n][j] * acc[m][n][j];
        acc[m][n] = (f32x4){0.f, 0.f, 0.f, 0.f};
      }
  }
};
struct MergeHook4 {
  f32x4 (&acc)[4][4]; f32x4 (&mg)[4][4]; const h16* gp;
  DEV void prefetch(int) {}
  DEV void apply(int b) {
#pragma unroll
    for (int m = 0; m < 4; ++m) {
      h16x4 gt[4];
#pragma unroll
      for (int n = 0; n < 4; ++n) gt[n] = *(const h16x4*)(gp + (size_t)m * 16 * 4096 + b * 1024 + n * 16);
#pragma unroll
      for (int n = 0; n < 4; ++n) {
#pragma unroll
        for (int j = 0; j < 4; ++j) mg[m][n][j] += (float)gt[n][j] * acc[m][n][j];
        acc[m][n] = (f32x4){0.f, 0.f, 0.f, 0.f};
      }
    }
  }
};
DEV void gemmU_phase(const Params& p, char* smem, int bid, int nb) {
  const int lane = tidx() & 63, wave = tidx() >> 6, wr = wave >> 1, wc = wave & 1;
  const h16* G = p.P;
  h16* merged = p.h;
  for_tiles_xcd<136, 8>(bid, nb, [&](int tm, int tn) {
    f32x4 mg[4][4], acc[4][4];
#pragma unroll
    for (int m = 0; m < 4; ++m)
#pragma unroll
      for (int n = 0; n < 4; ++n) { mg[m][n] = (f32x4){0.f, 0.f, 0.f, 0.f}; acc[m][n] = mg[m][n]; }
    const int row0 = tm * 128 + wr * 64 + (lane & 15), col0 = tn * 128 + wc * 64 + (lane >> 4) * 4;
    MergeHook4 hook{acc, mg, G + (size_t)row0 * 4096 + col0};
    gemm_kloop<4, DM, 1024, 16, 3, 1, MergeHook4>(p.o + (size_t)tm * 128 * DM, p.WT + WT_BR + (size_t)(tn * 128) * 1024, acc, smem, hook);
#pragma unroll
    for (int m = 0; m < 4; ++m)
#pragma unroll
      for (int n = 0; n < 4; ++n) {
        h16x4 o = {(h16)mg[m][n][0], (h16)mg[m][n][1], (h16)mg[m][n][2], (h16)mg[m][n][3]};
        *(h16x4*)(merged + (size_t)(row0 + m * 16) * DM + col0 + n * 16) = o;
      }
  });
}

template <int NK>
DEV void gemm_res_phase(const Params& p, int l, bool first, const h16* A, const h16* Wt, char* smem, int bid, int nb) {
  const int lane = tidx() & 63, wave = tidx() >> 6, wr = wave >> 1, wc = wave & 1;
  for_tiles_xcd<136, 8>(bid, nb, [&](int tm, int tn) {
    f32x4 acc[4][4];
#pragma unroll
    for (int m = 0; m < 4; ++m)
#pragma unroll
      for (int n = 0; n < 4; ++n) acc[m][n] = (f32x4){0.f, 0.f, 0.f, 0.f};
    gemm_kloop<4, NK * 64, NK * 64, NK, 3>(A + (size_t)tm * 128 * (NK * 64), Wt + (size_t)tn * 128 * (NK * 64), acc, smem);
#pragma unroll
    for (int m = 0; m < 4; ++m) {
      const int row = tm * 128 + wr * 64 + m * 16 + (lane & 15);
      const float* xin = first ? xrow_in(p, l, row) : p.out + (size_t)row * DM;
      float* xo = p.out + (size_t)row * DM;
#pragma unroll
      for (int n = 0; n < 4; ++n) {
        const int col = tn * 128 + wc * 64 + n * 16 + (lane >> 4) * 4;
        float4 xv;
        if (first) { const f32x4 t_ = __builtin_nontemporal_load((const f32x4*)(xin + col)); xv = make_float4(t_[0], t_[1], t_[2], t_[3]); }
        else xv = *(const float4*)(xin + col);
        *(float4*)(xo + col) = make_float4(xv.x + acc[m][n][0], xv.y + acc[m][n][1], xv.z + acc[m][n][2], xv.w + acc[m][n][3]);
      }
    }
  });
}

DEV void gemm4_phase(const Params& p, char* smem, int bid, int nb) {
  const int lane = tidx() & 63, wave = tidx() >> 6, wr = wave >> 1, wc = wave & 1;
  h16* act = p.P;
  for_tiles_xcd<136, 44>(bid, nb, [&](int tm, int tn) {
    f32x4 acc[4][4];
#pragma unroll
    for (int m = 0; m < 4; ++m)
#pragma unroll
      for (int n = 0; n < 4; ++n) acc[m][n] = (f32x4){0.f, 0.f, 0.f, 0.f};
    gemm_kloop<4, DM, 1024, 16, 3>(p.h + (size_t)tm * 128 * DM, p.WT + WT_FIN + (size_t)tn * 128 * 1024, acc, smem);
#pragma unroll
    for (int m = 0; m < 4; ++m) {
      const int row = tm * 128 + wr * 64 + m * 16 + (lane & 15);
#pragma unroll
      for (int n = 0; n < 2; ++n) {
        const int hid = tn * 64 + wc * 32 + n * 16 + (lane >> 4) * 4;
        h16x4 o;
#pragma unroll
        for (int j = 0; j < 4; ++j) o[j] = (h16)(silu(acc[m][n][j]) * acc[m][n + 2][j]);
        *(h16x4*)(act + (size_t)row * DFF + hid) = o;
      }
    }
  });
}

DEV void prep_phase(const Params& p, int l, char* smem, int bid, int nb) {
  h16* s_wd16 = (h16*)smem;
  h16* s_ad16 = s_wd16 + 16 * 72;
  const int tid = tidx();
  const float* mu = p.rw_mu + l * 1024;
  if (l == 0) {
    for (int e = bid * 256 + tid; e < 2056 * 32; e += nb * 256) {
      const int pi = e >> 5, i = e & 31;
      const float pos = pi < 2048 ? (float)pi : (float)(16384 + pi - 2048);
      const float inv = powf(10000.f, -(float)i / 32.f);
      const float ang = pos * inv;
      double rev = (double)ang * 0.15915494309189535;
      rev -= rint(rev);
      p.rope[pi * 64 + i] = __builtin_amdgcn_cosf((float)rev);
      p.rope[pi * 64 + 32 + i] = __builtin_amdgcn_sinf((float)rev);
    }
  }
  for (int s = bid; s < 136; s += nb) {
    const int tok = s < 8 ? s * 2048 + 2047 : M_PROMPT + (s - 8) * 8 + 7;
    float* dst = s < 8 ? p.out + O_PSH + (size_t)(l * 8 + s) * 1024 : p.out + O_SSH + (size_t)(l * 128 + (s - 8)) * 1024;
    for (int c = tid; c < 1024; c += 256) dst[c] = (float)p.P[(size_t)tok * NPC + C_RW + c];
  }
  for (int tile = bid; tile < M_TOK / 16; tile += nb) {
    const int tok0 = tile * 16;
    {
      const int tt = tid >> 4, c8 = (tid & 15) * 8, tok = tok0 + tt;
      const int col = c8 < 64 ? 256 + c8 : 832 + (c8 - 64);
      int tpos, b;
      if (tok < M_PROMPT) { tpos = tok & 2047; b = -1; } else { tpos = (tok - M_PROMPT) & 7; b = (tok - M_PROMPT) >> 3; }
      const h16x8 cur = *(const h16x8*)(p.P + (size_t)tok * NPC + C_RW + col);
      float pv[8];
      if (tpos > 0) { const h16x8 pr = *(const h16x8*)(p.P + (size_t)(tok - 1) * NPC + C_RW + col);
#pragma unroll
        for (int i = 0; i < 8; ++i) pv[i] = (float)pr[i]; }
      else if (b >= 0) {
#pragma unroll
        for (int i = 0; i < 8; ++i) pv[i] = p.st_shift[(size_t)(l * 128 + b) * 1024 + col + i]; }
      else {
#pragma unroll
        for (int i = 0; i < 8; ++i) pv[i] = 0.f; }
      h16x8 m8;
#pragma unroll
      for (int i = 0; i < 8; ++i) {
        const float c = (float)cur[i];
        float mval = c + (pv[i] - c) * mu[col + i];
        m8[i] = (h16)(c8 < 64 ? 1.f - 2.f * __builtin_amdgcn_rcpf(1.f + __expf(2.f * mval)) : mval);
      }
      *(h16x8*)((c8 < 64 ? s_wd16 : s_ad16) + tt * 72 + (c8 & 63)) = m8;
    }
    __syncthreads();
    {
      const int lane = tid & 63, wv = tid >> 6;
      h16x8 aw[2], aa[2];
#pragma unroll
      for (int ks = 0; ks < 2; ++ks) {
        aw[ks] = *(const h16x8*)(s_wd16 + (lane & 15) * 72 + ks * 32 + (lane >> 4) * 8);
        aa[ks] = *(const h16x8*)(s_ad16 + (lane & 15) * 72 + ks * 32 + (lane >> 4) * 8);
      }
#pragma unroll
      for (int ct = 0; ct < 4; ++ct) {
        const int col = (wv * 4 + ct) * 16 + (lane & 15);
        const h16* bw = p.lora + 256 * 128 + (size_t)col * 64 + (lane >> 4) * 8;
        const h16* ba_ = bw + 256 * 64;
        f32x4 cw = {0.f, 0.f, 0.f, 0.f}, ca = {0.f, 0.f, 0.f, 0.f};
#pragma unroll
        for (int ks = 0; ks < 2; ++ks) {
          cw = __builtin_amdgcn_mfma_f32_16x16x32_f16(aw[ks], *(const h16x8*)(bw + ks * 32), cw, 0, 0, 0);
          ca = __builtin_amdgcn_mfma_f32_16x16x32_f16(aa[ks], *(const h16x8*)(ba_ + ks * 32), ca, 0, 0, 0);
        }
        const float w0c = p.rw_w0[l * 256 + col], a0c = p.rw_a0[l * 256 + col];
#pragma unroll
        for (int r = 0; r < 4; ++r) {
          h16* dst = p.RWp + (size_t)(tok0 + (lane >> 4) * 4 + r) * 512 + col;
          dst[0] = (h16)__expf(-0.6065306597126334f * sigm(w0c + cw[r]));
          dst[256] = (h16)sigm(a0c + ca[r]);
        }
      }
    }
    {
      const int lane = tid & 63, wv = tid >> 6;
      float* s_pa = (float*)(smem + 8192);
      const h16* ha = p.h + (size_t)(tok0 + (lane & 15)) * DM + (lane >> 4) * 8;
      const h16* wb = p.WT + WT_IN + (size_t)(3840 + (lane & 15)) * 1024 + (lane >> 4) * 8;
      f32x4 c = {0.f, 0.f, 0.f, 0.f};
#pragma unroll
      for (int ks = 0; ks < 8; ++ks) c = __builtin_amdgcn_mfma_f32_16x16x32_f16(*(const h16x8*)(ha + (wv * 8 + ks) * 32), *(const h16x8*)(wb + (wv * 8 + ks) * 32), c, 0, 0, 0);
#pragma unroll
      for (int r = 0; r < 4; ++r) s_pa[(wv * 16 + (lane >> 4) * 4 + r) * 16 + (lane & 15)] = c[r];
      __syncthreads();
      const int t = tid >> 4, cc = tid & 15;
      const float v = s_pa[(0 * 16 + t) * 16 + cc] + s_pa[(1 * 16 + t) * 16 + cc] + s_pa[(2 * 16 + t) * 16 + cc] + s_pa[(3 * 16 + t) * 16 + cc];
      p.P[(size_t)(tok0 + t) * NPC + C_GLA + cc] = (h16)v;
    }
    __syncthreads();
  }
}

struct Raw { h16x4 a, b, c, d, e, f; h16 v, vp; h16x8 g0, g1; };

template <int MX> DEV void recur_item(const Params& p, int l, int s, int hd, int vq, char* smem) {
  constexpr int DK = (MX == 1) ? 32 : 64, KPL = DK / 16, T = 16;
  constexpr int BUF = (5 * T * 64 + 2 * T * 16) * 4;
  const int tid = tidx(), lane = tid & 63, wave = tid >> 6, vl = lane >> 4, kg = lane & 15;
  const bool prompt = s < 8;
  const int L = prompt ? 2048 : 8, tok0 = prompt ? s * 2048 : M_PROMPT + (s - 8) * 8, b = prompt ? s : s - 8;
  const int pos0 = prompt ? 0 : 2048;
  const int st = tid >> 4, sj = tid & 15;
  const int vcol = vq * 16 + wave * 4 + vl;

  float c0[4] = {0.f, 0.f, 0.f, 0.f}, c1[4] = {0.f, 0.f, 0.f, 0.f}, c2[4] = {0.f, 0.f, 0.f, 0.f}, c3[4] = {0.f, 0.f, 0.f, 0.f}, cv = 0.f;
  float wa[2][16]; float ba[2] = {0.f, 0.f};
  if (MX == 0) {
#pragma unroll
    for (int i = 0; i < 4; ++i) { const int c = hd * 64 + sj * 4 + i; c0[i] = l == 0 ? 0.f : 1.f / (1.f + __expf(p.hg_lb_logits[c] - p.hg_lb_logits[256 + c])); }
  } else if (MX == 1) {
#pragma unroll
    for (int i = 0; i < 2; ++i) { const int c = hd * 32 + sj * 2 + i; ba[i] = p.gla_ba[l * 128 + c];
#pragma unroll
      for (int r = 0; r < 16; ++r) wa[i][r] = p.gla_wa2[(size_t)l * 2048 + r * 128 + c]; }
  } else if (MX == 2) {
#pragma unroll
    for (int i = 0; i < 4; ++i) { const int c = hd * 64 + sj * 4 + i; c0[i] = p.rw_mu[l * 1024 + c]; c1[i] = p.rw_mu[l * 1024 + 320 + c]; c2[i] = p.rw_ka[l * 256 + c]; c3[i] = p.rw_kk[l * 256 + c]; }
    cv = p.rw_mu[l * 1024 + 576 + hd * 64 + vq * 16 + sj];
  }
  (void)wa; (void)ba; (void)c1; (void)c2; (void)c3; (void)cv;

  float S[KPL];
  {
    const float* sp = nullptr;
    if (!prompt) {
      if (MX == 0) sp = p.st_hg + ((size_t)(l * 128 + b) * 4 + hd) * 64 * 64;
      if (MX == 1) sp = p.st_gla + ((size_t)(l * 128 + b) * 4 + hd) * 32 * 64;
      if (MX == 2) sp = p.st_rw + ((size_t)(l * 128 + b) * 4 + hd) * 64 * 64;
      if (MX == 3) sp = p.st_ret + ((size_t)(l * 128 + b) * 4 + hd) * 64 * 64;
    }
#pragma unroll
    for (int i = 0; i < KPL; ++i) S[i] = prompt ? 0.f : sp[(kg * KPL + i) * 64 + vcol];
  }
  f32x2 SA = {S[0], S[1]}, SB = {S[KPL - 2], S[KPL - 1]};
  const float gam = 1.f - exp2f(-5.f - (float)hd);

  auto load_raw = [&](int tb, Raw& r) {
    const int t = tb + st;
    if (t >= L) return;
    const h16* pr = p.P + (size_t)(tok0 + t) * NPC;
    if (MX == 0) {
      r.a = *(const h16x4*)(pr + C_HGQ + hd * 64 + sj * 4); r.b = *(const h16x4*)(pr + C_HGF + hd * 64 + sj * 4);
      r.v = pr[C_HGI + hd * 64 + vq * 16 + sj];
    } else if (MX == 1) {
      const h16x2 q2 = *(const h16x2*)(pr + C_GLQ + hd * 32 + sj * 2), k2 = *(const h16x2*)(pr + C_GLK + hd * 32 + sj * 2);
      r.a[0] = q2[0]; r.a[1] = q2[1]; r.a[2] = k2[0]; r.a[3] = k2[1];
      r.g0 = *(const h16x8*)(pr + C_GLA); r.g1 = *(const h16x8*)(pr + C_GLA + 8);
      r.v = pr[C_GLV + hd * 64 + vq * 16 + sj];
    } else if (MX == 2) {
      r.a = *(const h16x4*)(pr + C_RW + hd * 64 + sj * 4); r.b = *(const h16x4*)(pr + C_RW + 320 + hd * 64 + sj * 4);
      r.v = pr[C_RW + 576 + hd * 64 + vq * 16 + sj];
      if (t > 0) {
        r.c = *(const h16x4*)(pr - NPC + C_RW + hd * 64 + sj * 4); r.d = *(const h16x4*)(pr - NPC + C_RW + 320 + hd * 64 + sj * 4);
        r.vp = *(pr - NPC + C_RW + 576 + hd * 64 + vq * 16 + sj);
      } else if (!prompt) {
        const float* sh = p.st_shift + (size_t)(l * 128 + b) * 1024;
#pragma unroll
        for (int i = 0; i < 4; ++i) { r.c[i] = (h16)0.f; r.d[i] = (h16)0.f; }
        (void)sh; r.vp = (h16)0.f;
      } else {
#pragma unroll
        for (int i = 0; i < 4; ++i) { r.c[i] = (h16)0.f; r.d[i] = (h16)0.f; }
        r.vp = (h16)0.f;
      }
      const h16* rw = p.RWp + (size_t)(tok0 + t) * 512;
      r.e = *(const h16x4*)(rw + hd * 64 + sj * 4); r.f = *(const h16x4*)(rw + 256 + hd * 64 + sj * 4);
    } else {
      const int base = sj < 8 ? C_RTQ : C_RTK, i4 = (sj & 7) * 4;
      r.a = *(const h16x4*)(pr + base + hd * 64 + i4); r.b = *(const h16x4*)(pr + base + hd * 64 + 32 + i4);
      r.v = pr[C_RTV + hd * 64 + vq * 16 + sj];
    }
  };

  auto process = [&](int tb, const Raw& r, char* buf) {
    float* sq = (float*)buf; float* sk = sq + T * 64; float* sg = sk + T * 64; float* skk = sg + T * 64; float* sak = skk + T * 64;
    float* sv = sak + T * 64;
    const int t = tb + st;
    const bool valid = t < L;
    if (MX == 0) {
      if (valid) {
        float4 qo, ko, go;
        float* qp = (float*)&qo; float* kp = (float*)&ko; float* gp = (float*)&go;
#pragma unroll
        for (int i = 0; i < 4; ++i) {
          const float f = c0[i] + (1.f - c0[i]) * sigm((float)r.b[i]);
          qp[i] = silu((float)r.a[i]); kp[i] = 1.f - f; gp[i] = fmaxf(f, 1e-30f);
        }
        *(float4*)(sq + st * 64 + sj * 4) = qo; *(float4*)(sk + st * 64 + sj * 4) = ko; *(float4*)(sg + st * 64 + sj * 4) = go;
        sv[st * 16 + sj] = (float)r.v;
      }
    } else if (MX == 1) {
      if (valid) {
#pragma unroll
        for (int i = 0; i < 2; ++i) {
          float z = ba[i];
#pragma unroll
          for (int rr = 0; rr < 8; ++rr) z += (float)r.g0[rr] * wa[i][rr] + (float)r.g1[rr] * wa[i][8 + rr];
          const float ls = fminf(z, 0.f) - __logf(1.f + __expf(-fabsf(z)));
          sq[st * 64 + sj * 2 + i] = (float)r.a[i] * 0.17677669529663687f;
          sk[st * 64 + sj * 2 + i] = (float)r.a[2 + i];
          sg[st * 64 + sj * 2 + i] = __expf(ls * 0.0625f);
        }
        sv[st * 16 + sj] = (float)r.v;
      }
    } else if (MX == 2) {
      float rr[4], kk[4], kr[4], ak[4], ww[4], ss = 0.f, vv = 0.f;
      if (valid) {
        float pc[4], pd[4], pvv = (float)r.vp;
#pragma unroll
        for (int i = 0; i < 4; ++i) { pc[i] = (float)r.c[i]; pd[i] = (float)r.d[i]; }
        if (t == 0 && !prompt) {
          const float* sh = p.st_shift + (size_t)(l * 128 + b) * 1024;
#pragma unroll
          for (int i = 0; i < 4; ++i) { pc[i] = sh[hd * 64 + sj * 4 + i]; pd[i] = sh[320 + hd * 64 + sj * 4 + i]; }
          pvv = sh[576 + hd * 64 + vq * 16 + sj];
        }
#pragma unroll
        for (int i = 0; i < 4; ++i) {
          const float rc = (float)r.a[i], kc = (float)r.b[i];
          rr[i] = rc + (pc[i] - rc) * c0[i];
          const float km = kc + (pd[i] - kc) * c1[i];
          const float a = (float)r.f[i];
          ww[i] = (float)r.e[i];
          kk[i] = km * (1.f + (a - 1.f) * c2[i]);
          kr[i] = km * c3[i];
          ak[i] = a;
          ss += kr[i] * kr[i];
        }
        const float vc = (float)r.v;
        vv = vc + (pvv - vc) * cv;
      } else {
#pragma unroll
        for (int i = 0; i < 4; ++i) { rr[i] = kk[i] = kr[i] = ak[i] = ww[i] = 0.f; }
      }
      ss = row16_sum(ss);
      if (valid) {
        const float inv = fminf(__builtin_amdgcn_rsqf(ss), 1e12f);
        float4 o0 = make_float4(rr[0], rr[1], rr[2], rr[3]), o1 = make_float4(kk[0], kk[1], kk[2], kk[3]), o2 = make_float4(ww[0], ww[1], ww[2], ww[3]);
        float4 o3 = make_float4(kr[0] * inv, kr[1] * inv, kr[2] * inv, kr[3] * inv);
        float4 o4 = make_float4(o3.x * ak[0], o3.y * ak[1], o3.z * ak[2], o3.w * ak[3]);
        *(float4*)(sq + st * 64 + sj * 4) = o0; *(float4*)(sk + st * 64 + sj * 4) = o1; *(float4*)(sg + st * 64 + sj * 4) = o2;
        *(float4*)(skk + st * 64 + sj * 4) = o3; *(float4*)(sak + st * 64 + sj * 4) = o4;
        sv[st * 16 + sj] = vv;
      }
    } else {
      if (valid) {
        const int i4 = (sj & 7) * 4;
        const float* rp = p.rope + (size_t)(pos0 + t) * 64;
        const float4 cs = *(const float4*)(rp + i4), sn = *(const float4*)(rp + 32 + i4);
        const float* cp = (const float*)&cs; const float* sp = (const float*)&sn;
        const float sc = sj < 8 ? 1.f : 0.125f;
        float* dst = sj < 8 ? sq : sk;
        float4 o1, o2; float* p1 = (float*)&o1; float* p2 = (float*)&o2;
#pragma unroll
        for (int i = 0; i < 4; ++i) {
          const float x1 = (float)r.a[i], x2 = (float)r.b[i];
          p1[i] = (x1 * cp[i] - x2 * sp[i]) * sc; p2[i] = (x1 * sp[i] + x2 * cp[i]) * sc;
        }
        *(float4*)(dst + st * 64 + i4) = o1; *(float4*)(dst + st * 64 + 32 + i4) = o2;
        sv[st * 16 + sj] = (float)r.v;
      }
    }
  };

  auto flush = [&](int tb, const char* buf) {
    const float* so = (const float*)buf + 5 * T * 64 + T * 16;
    const int t = tb + st;
    if (t < L) p.o[(size_t)(tok0 + t) * DM + MX * 256 + hd * 64 + vq * 16 + sj] = (h16)so[st * 16 + sj];
  };

  const int nbat = (L + T - 1) / T;
  Raw raw;
  __builtin_amdgcn_s_waitcnt(0x0F70);
  load_raw(0, raw);
  for (int bt = 0; bt < nbat; ++bt) {
    char* buf = smem + (bt & 1) * BUF;
    process(bt * T, raw, buf);
    __syncthreads();
    if (bt > 0) flush((bt - 1) * T, smem + ((bt - 1) & 1) * BUF);
    if (bt + 1 < nbat) load_raw((bt + 1) * T, raw);
    {
      const float* sq = (const float*)buf; const float* sk = sq + T * 64; const float* sg = sk + T * 64; const float* skk = sg + T * 64;
      const float* sak = skk + T * 64; const float* sv = sak + T * 64; float* so = (float*)sv + T * 16;
      const int nt = min(T, L - bt * T);
      constexpr int GS = (MX == 2) ? 2 : 4;
      for (int t0 = 0; t0 < nt; t0 += GS) {
        float vv[GS], part[GS];
#pragma unroll
        for (int u = 0; u < GS; ++u) vv[u] = sv[(t0 + u) * 16 + wave * 4 + vl];
        if constexpr (MX == 2) {
          f32x4 r4[GS], k4[GS], w4[GS], n4[GS], a4[GS];
#pragma unroll
          for (int u = 0; u < GS; ++u) {
            const int o_ = (t0 + u) * 64 + kg * 4;
            r4[u] = *(const f32x4*)(sq + o_); k4[u] = *(const f32x4*)(sk + o_); w4[u] = *(const f32x4*)(sg + o_);
            n4[u] = *(const f32x4*)(skk + o_); a4[u] = *(const f32x4*)(sak + o_);
          }
#pragma unroll
          for (int u = 0; u < GS; ++u) {
            const f32x2 d = n4[u].xy * SA + n4[u].zw * SB;
            const float ks = row16_sum(d.x + d.y);
            const f32x2 ta = k4[u].xy * vv[u] - a4[u].xy * ks, tb = k4[u].zw * vv[u] - a4[u].zw * ks;
            SA = w4[u].xy * SA + ta; SB = w4[u].zw * SB + tb;
            const f32x2 e = r4[u].xy * SA + r4[u].zw * SB;
            part[u] = e.x + e.y;
          }
        } else if constexpr (MX == 1) {
          f32x2 q2[GS], k2[GS], g2[GS];
#pragma unroll
          for (int u = 0; u < GS; ++u) {
            const int o_ = (t0 + u) * 64 + kg * 2;
            q2[u] = *(const f32x2*)(sq + o_); k2[u] = *(const f32x2*)(sk + o_); g2[u] = *(const f32x2*)(sg + o_);
          }
#pragma unroll
          for (int u = 0; u < GS; ++u) {
            SA = g2[u] * SA + k2[u] * vv[u];
            const f32x2 e = q2[u] * SA;
            part[u] = e.x + e.y;
          }
        } else {
          f32x4 q4[GS], k4[GS], g4[GS];
#pragma unroll
          for (int u = 0; u < GS; ++u) {
            const int o_ = (t0 + u) * 64 + kg * 4;
            q4[u] = *(const f32x4*)(sq + o_); k4[u] = *(const f32x4*)(sk + o_);
            if (MX == 0) g4[u] = *(const f32x4*)(sg + o_); else g4[u] = (f32x4){gam, gam, gam, gam};
          }
#pragma unroll
          for (int u = 0; u < GS; ++u) {
            SA = g4[u].xy * SA + k4[u].xy * vv[u]; SB = g4[u].zw * SB + k4[u].zw * vv[u];
            const f32x2 e = q4[u].xy * SA + q4[u].zw * SB;
            part[u] = e.x + e.y;
          }
        }
#pragma unroll
        for (int u = 0; u < GS; ++u) part[u] = row16_sum(part[u]);
        if (kg == 0) {
#pragma unroll
          for (int u = 0; u < GS; ++u) so[(t0 + u) * 16 + wave * 4 + vl] = part[u];
        }
      }
    }
  }
  __syncthreads();
  flush((nbat - 1) * T, smem + ((nbat - 1) & 1) * BUF);
  {
    float* dp;
    if (MX == 0) dp = p.out + (prompt ? O_PHG + ((size_t)(l * 8 + b) * 4 + hd) * 4096 : O_SHG + ((size_t)(l * 128 + b) * 4 + hd) * 4096);
    else if (MX == 1) dp = p.out + (prompt ? O_PGLA + ((size_t)(l * 8 + b) * 4 + hd) * 2048 : O_SGLA + ((size_t)(l * 128 + b) * 4 + hd) * 2048);
    else if (MX == 2) dp = p.out + (prompt ? O_PRW + ((size_t)(l * 8 + b) * 4 + hd) * 4096 : O_SRW + ((size_t)(l * 128 + b) * 4 + hd) * 4096);
    else dp = p.out + (prompt ? O_PRET + ((size_t)(l * 8 + b) * 4 + hd) * 4096 : O_SRET + ((size_t)(l * 128 + b) * 4 + hd) * 4096);
    S[0] = SA.x; S[1] = SA.y;
    if (KPL == 4) { S[KPL - 2] = SB.x; S[KPL - 1] = SB.y; }
#pragma unroll
    for (int i = 0; i < KPL; ++i) dp[(kg * KPL + i) * 64 + vcol] = S[i];
  }
  __syncthreads();
}


template <int MX> DEV void recur_sample(const Params& p, int l, int bp, int hd, char* smem) {
  constexpr int DK = (MX == 1) ? 32 : 64, KPL = DK / 16, T = 16;
  const int tid = tidx(), lane = tid & 63, wave = tid >> 6, vl = lane >> 4, kg = lane & 15;
  const int st = tid >> 4, sj = tid & 15;
  const int b_st = 2 * bp + (st >> 3), t = st & 7, tok = M_PROMPT + b_st * 8 + t;
  float* sq = (float*)smem; float* sk = sq + T * 64; float* sg = sk + T * 64; float* skk = sg + T * 64; float* sak = skk + T * 64;
  float* sv = sak + T * 64; float* so = sv + T * 64;
  const float* stin; float* stout;
  if (MX == 0) { stin = p.st_hg + ((size_t)(l * 128 + 2 * bp) * 4 + hd) * 4096; stout = p.out + O_SHG + ((size_t)(l * 128 + 2 * bp) * 4 + hd) * 4096; }
  else if (MX == 1) { stin = p.st_gla + ((size_t)(l * 128 + 2 * bp) * 4 + hd) * 2048; stout = p.out + O_SGLA + ((size_t)(l * 128 + 2 * bp) * 4 + hd) * 2048; }
  else if (MX == 2) { stin = p.st_rw + ((size_t)(l * 128 + 2 * bp) * 4 + hd) * 4096; stout = p.out + O_SRW + ((size_t)(l * 128 + 2 * bp) * 4 + hd) * 4096; }
  else { stin = p.st_ret + ((size_t)(l * 128 + 2 * bp) * 4 + hd) * 4096; stout = p.out + O_SRET + ((size_t)(l * 128 + 2 * bp) * 4 + hd) * 4096; }
  constexpr int SEQ_STRIDE = 4 * DK * 64;
  const int lofs = kg * KPL * 64 + wave * 4 + vl;
  float S[KPL], Sn[KPL];
#pragma unroll
  for (int i = 0; i < KPL; ++i) S[i] = stin[lofs + i * 64];
  const float gam = 1.f - exp2f(-5.f - (float)hd);
  const h16* pr = p.P + (size_t)tok * NPC;
  if (MX == 0) {
    const h16x4 q4 = *(const h16x4*)(pr + C_HGQ + hd * 64 + sj * 4), f4 = *(const h16x4*)(pr + C_HGF + hd * 64 + sj * 4);
    const h16x4 v4 = *(const h16x4*)(pr + C_HGI + hd * 64 + sj * 4);
    float4 qo, ko, go; float* qp = (float*)&qo; float* kp = (float*)&ko; float* gp = (float*)&go;
#pragma unroll
    for (int i = 0; i < 4; ++i) {
      const int c = hd * 64 + sj * 4 + i;
      const float lb = l == 0 ? 0.f : 1.f / (1.f + __expf(p.hg_lb_logits[c] - p.hg_lb_logits[256 + c]));
      const float f = lb + (1.f - lb) * sigm((float)f4[i]);
      qp[i] = silu((float)q4[i]); kp[i] = 1.f - f; gp[i] = fmaxf(f, 1e-30f);
    }
    *(float4*)(sq + st * 64 + sj * 4) = qo; *(float4*)(sk + st * 64 + sj * 4) = ko; *(float4*)(sg + st * 64 + sj * 4) = go;
    *(float4*)(sv + st * 64 + sj * 4) = make_float4((float)v4[0], (float)v4[1], (float)v4[2], (float)v4[3]);
  } else if (MX == 1) {
    const h16x2 q2 = *(const h16x2*)(pr + C_GLQ + hd * 32 + sj * 2), k2 = *(const h16x2*)(pr + C_GLK + hd * 32 + sj * 2);
    const h16x8 g0 = *(const h16x8*)(pr + C_GLA), g1 = *(const h16x8*)(pr + C_GLA + 8);
    const h16x4 v4 = *(const h16x4*)(pr + C_GLV + hd * 64 + sj * 4);
#pragma unroll
    for (int i = 0; i < 2; ++i) {
      const int c = hd * 32 + sj * 2 + i;
      float z = p.gla_ba[l * 128 + c];
#pragma unroll
      for (int rr = 0; rr < 8; ++rr) z += (float)g0[rr] * p.gla_wa2[(size_t)l * 2048 + rr * 128 + c] + (float)g1[rr] * p.gla_wa2[(size_t)l * 2048 + (8 + rr) * 128 + c];
      const float ls = fminf(z, 0.f) - __logf(1.f + __expf(-fabsf(z)));
      sq[st * 64 + sj * 2 + i] = (float)q2[i] * 0.17677669529663687f;
      sk[st * 64 + sj * 2 + i] = (float)k2[i];
      sg[st * 64 + sj * 2 + i] = __expf(ls * 0.0625f);
    }
    *(float4*)(sv + st * 64 + sj * 4) = make_float4((float)v4[0], (float)v4[1], (float)v4[2], (float)v4[3]);
  } else if (MX == 2) {
    const h16x4 r4 = *(const h16x4*)(pr + C_RW + hd * 64 + sj * 4), k4 = *(const h16x4*)(pr + C_RW + 320 + hd * 64 + sj * 4);
    const h16x4 v4 = *(const h16x4*)(pr + C_RW + 576 + hd * 64 + sj * 4);
    const h16* rw = p.RWp + (size_t)tok * 512;
    const h16x4 w4 = *(const h16x4*)(rw + hd * 64 + sj * 4), a4 = *(const h16x4*)(rw + 256 + hd * 64 + sj * 4);
    float pc[4], pd[4], pv[4];
    if (t > 0) {
      const h16x4 c4 = *(const h16x4*)(pr - NPC + C_RW + hd * 64 + sj * 4), d4 = *(const h16x4*)(pr - NPC + C_RW + 320 + hd * 64 + sj * 4);
      const h16x4 e4 = *(const h16x4*)(pr - NPC + C_RW + 576 + hd * 64 + sj * 4);
#pragma unroll
      for (int i = 0; i < 4; ++i) { pc[i] = (float)c4[i]; pd[i] = (float)d4[i]; pv[i] = (float)e4[i]; }
    } else {
      const float* sh = p.st_shift + (size_t)(l * 128 + b_st) * 1024;
#pragma unroll
      for (int i = 0; i < 4; ++i) { pc[i] = sh[hd * 64 + sj * 4 + i]; pd[i] = sh[320 + hd * 64 + sj * 4 + i]; pv[i] = sh[576 + hd * 64 + sj * 4 + i]; }
    }
    float rr[4], kk[4], kr[4], ak[4], ww[4], vv[4], ss = 0.f;
#pragma unroll
    for (int i = 0; i < 4; ++i) {
      const int c = hd * 64 + sj * 4 + i;
      const float rc = (float)r4[i], kc = (float)k4[i], vc = (float)v4[i];
      rr[i] = rc + (pc[i] - rc) * p.rw_mu[l * 1024 + c];
      const float km = kc + (pd[i] - kc) * p.rw_mu[l * 1024 + 320 + c];
      vv[i] = vc + (pv[i] - vc) * p.rw_mu[l * 1024 + 576 + c];
      const float a = (float)a4[i];
      ww[i] = (float)w4[i];
      kk[i] = km * (1.f + (a - 1.f) * p.rw_ka[l * 256 + c]);
      kr[i] = km * p.rw_kk[l * 256 + c];
      ak[i] = a;
      ss += kr[i] * kr[i];
    }
    ss = row16_sum(ss);
    const float inv = fminf(__builtin_amdgcn_rsqf(ss), 1e12f);
    const float4 o3 = make_float4(kr[0] * inv, kr[1] * inv, kr[2] * inv, kr[3] * inv);
    *(float4*)(sq + st * 64 + sj * 4) = make_float4(rr[0], rr[1], rr[2], rr[3]);
    *(float4*)(sk + st * 64 + sj * 4) = make_float4(kk[0], kk[1], kk[2], kk[3]);
    *(float4*)(sg + st * 64 + sj * 4) = make_float4(ww[0], ww[1], ww[2], ww[3]);
    *(float4*)(skk + st * 64 + sj * 4) = o3;
    *(float4*)(sak + st * 64 + sj * 4) = make_float4(o3.x * ak[0], o3.y * ak[1], o3.z * ak[2], o3.w * ak[3]);
    *(float4*)(sv + st * 64 + sj * 4) = make_float4(vv[0], vv[1], vv[2], vv[3]);
  } else {
    const int base = sj < 8 ? C_RTQ : C_RTK, i4 = (sj & 7) * 4;
    const h16x4 x1 = *(const h16x4*)(pr + base + hd * 64 + i4), x2 = *(const h16x4*)(pr + base + hd * 64 + 32 + i4);
    const h16x4 v4 = *(const h16x4*)(pr + C_RTV + hd * 64 + sj * 4);
    const float* rp = p.rope + (size_t)(2048 + t) * 64;
    const float4 cs = *(const float4*)(rp + i4), sn = *(const float4*)(rp + 32 + i4);
    const float* cp = (const float*)&cs; const float* sp = (const float*)&sn;
    const float sc = sj < 8 ? 1.f : 0.125f;
    float* dst = sj < 8 ? sq : sk;
    float4 o1, o2; float* p1 = (float*)&o1; float* p2 = (float*)&o2;
#pragma unroll
    for (int i = 0; i < 4; ++i) {
      const float a = (float)x1[i], b2 = (float)x2[i];
      p1[i] = (a * cp[i] - b2 * sp[i]) * sc; p2[i] = (a * sp[i] + b2 * cp[i]) * sc;
    }
    *(float4*)(dst + st * 64 + i4) = o1; *(float4*)(dst + st * 64 + 32 + i4) = o2;
    *(float4*)(sv + st * 64 + sj * 4) = make_float4((float)v4[0], (float)v4[1], (float)v4[2], (float)v4[3]);
  }
  __builtin_amdgcn_s_waitcnt(0x0F70);
  __syncthreads();
#pragma nounroll
  for (int c = 0; c < 8; ++c) {
    const int seq = c >> 2, vq = c & 3, vcol = vq * 16 + wave * 4 + vl, rowb = seq * 8;
    if (c + 1 < 8) {
      const int o1_ = ((c + 1) >> 2) * SEQ_STRIDE + ((c + 1) & 3) * 16 + lofs;
#pragma unroll
      for (int i = 0; i < KPL; ++i) Sn[i] = stin[o1_ + i * 64];
    }
    f32x2 SA = {S[0], S[1]}, SB = {S[KPL - 2], S[KPL - 1]};
    constexpr int GS = (MX == 2) ? 2 : 4;
#pragma nounroll
    for (int t0 = 0; t0 < 8; t0 += GS) {
      float vv[GS], part[GS];
#pragma unroll
      for (int u = 0; u < GS; ++u) vv[u] = sv[(rowb + t0 + u) * 64 + vcol];
      if constexpr (MX == 2) {
        f32x4 r4[GS], k4[GS], w4[GS], n4[GS], a4[GS];
#pragma unroll
        for (int u = 0; u < GS; ++u) {
          const int o_ = (rowb + t0 + u) * 64 + kg * 4;
          r4[u] = *(const f32x4*)(sq + o_); k4[u] = *(const f32x4*)(sk + o_); w4[u] = *(const f32x4*)(sg + o_);
          n4[u] = *(const f32x4*)(skk + o_); a4[u] = *(const f32x4*)(sak + o_);
        }
#pragma unroll
        for (int u = 0; u < GS; ++u) {
          const f32x2 d = n4[u].xy * SA + n4[u].zw * SB;
          const float ks = row16_sum(d.x + d.y);
          const f32x2 ta = k4[u].xy * vv[u] - a4[u].xy * ks, tb = k4[u].zw * vv[u] - a4[u].zw * ks;
          SA = w4[u].xy * SA + ta; SB = w4[u].zw * SB + tb;
          const f32x2 e = r4[u].xy * SA + r4[u].zw * SB;
          part[u] = e.x + e.y;
        }
      } else if constexpr (MX == 1) {
        f32x2 q2[GS], k2[GS], g2[GS];
#pragma unroll
        for (int u = 0; u < GS; ++u) {
          const int o_ = (rowb + t0 + u) * 64 + kg * 2;
          q2[u] = *(const f32x2*)(sq + o_); k2[u] = *(const f32x2*)(sk + o_); g2[u] = *(const f32x2*)(sg + o_);
        }
#pragma unroll
        for (int u = 0; u < GS; ++u) {
          SA = g2[u] * SA + k2[u] * vv[u];
          const f32x2 e = q2[u] * SA;
          part[u] = e.x + e.y;
        }
      } else {
        f32x4 q4[GS], k4[GS], g4[GS];
#pragma unroll
        for (int u = 0; u < GS; ++u) {
          const int o_ = (rowb + t0 + u) * 64 + kg * 4;
          q4[u] = *(const f32x4*)(sq + o_); k4[u] = *(const f32x4*)(sk + o_);
          if (MX == 0) g4[u] = *(const f32x4*)(sg + o_); else g4[u] = (f32x4){gam, gam, gam, gam};
        }
#pragma unroll
        for (int u = 0; u < GS; ++u) {
          SA = g4[u].xy * SA + k4[u].xy * vv[u]; SB = g4[u].zw * SB + k4[u].zw * vv[u];
          const f32x2 e = q4[u].xy * SA + q4[u].zw * SB;
          part[u] = e.x + e.y;
        }
      }
#pragma unroll
      for (int u = 0; u < GS; ++u) part[u] = row16_sum(part[u]);
      if (kg == 0) {
#pragma unroll
        for (int u = 0; u < GS; ++u) so[(rowb + t0 + u) * 64 + vcol] = part[u];
      }
    }
    {
      float* dp = stout + seq * SEQ_STRIDE + vq * 16 + lofs;
      dp[0] = SA.x; dp[64] = SA.y;
      if (KPL == 4) { dp[128] = SB.x; dp[192] = SB.y; }
    }
#pragma unroll
    for (int i = 0; i < KPL; ++i) S[i] = Sn[i];
  }
  __syncthreads();
  {
    const float4 o = *(const float4*)(so + st * 64 + sj * 4);
    h16x4 oh = {(h16)o.x, (h16)o.y, (h16)o.z, (h16)o.w};
    *(h16x4*)(p.o + (size_t)tok * DM + MX * 256 + hd * 64 + sj * 4) = oh;
  }
  __syncthreads();
}


template <int MX> DEV void recur_wide(const Params& p, int l, int s, int hd, int vh, char* smem) {
  static_assert(MX != 2, "RWKV-7 needs the key reduction inside the step");
  constexpr int DK = (MX == 1) ? 32 : 64, KW = DK / 4, KL = KW / 2  , NP = KL / 2, T = 16;
  constexpr int IN_F = 4 * T * 64;
  constexpr int BUF = (IN_F + T * 4 * 64) * 4;
  const int tid = tidx(), lane = tid & 63, wave = tid >> 6, kh = lane >> 5, v32 = lane & 31;
  const int st = tid >> 4, sj = tid & 15;
  const int tok0 = s * 2048, L = 2048;
  const int krow0 = wave * KW + kh * KL;
  float c0[4] = {0.f, 0.f, 0.f, 0.f};
  float wa[2][16]; float ba[2] = {0.f, 0.f};
  if (MX == 0) {
#pragma unroll
    for (int i = 0; i < 4; ++i) { const int c = hd * 64 + sj * 4 + i; c0[i] = l == 0 ? 0.f : 1.f / (1.f + __expf(p.hg_lb_logits[c] - p.hg_lb_logits[256 + c])); }
  } else if (MX == 1) {
#pragma unroll
    for (int i = 0; i < 2; ++i) { const int c = hd * 32 + sj * 2 + i; ba[i] = p.gla_ba[l * 128 + c];
#pragma unroll
      for (int r = 0; r < 16; ++r) wa[i][r] = p.gla_wa2[(size_t)l * 2048 + r * 128 + c]; }
  }
  (void)wa; (void)ba; (void)c0;
  f32x2 S[NP];
#pragma unroll
  for (int j = 0; j < NP; ++j) S[j] = (f32x2){0.f, 0.f};
  const float gam = 1.f - exp2f(-5.f - (float)hd);

  auto load_raw = [&](int tb, Raw& r) {
    const h16* pr = p.P + (size_t)(tok0 + tb + st) * NPC;
    if (MX == 0) {
      r.a = *(const h16x4*)(pr + C_HGQ + hd * 64 + sj * 4); r.b = *(const h16x4*)(pr + C_HGF + hd * 64 + sj * 4);
      r.c = *(const h16x4*)(pr + C_HGI + hd * 64 + vh * 32 + (sj & 7) * 4);
    } else if (MX == 1) {
      const h16x2 q2 = *(const h16x2*)(pr + C_GLQ + hd * 32 + sj * 2), k2 = *(const h16x2*)(pr + C_GLK + hd * 32 + sj * 2);
      r.a[0] = q2[0]; r.a[1] = q2[1]; r.a[2] = k2[0]; r.a[3] = k2[1];
      r.g0 = *(const h16x8*)(pr + C_GLA); r.g1 = *(const h16x8*)(pr + C_GLA + 8);
      r.c = *(const h16x4*)(pr + C_GLV + hd * 64 + vh * 32 + (sj & 7) * 4);
    } else {
      const int base = sj < 8 ? C_RTQ : C_RTK, i4 = (sj & 7) * 4;
      r.a = *(const h16x4*)(pr + base + hd * 64 + i4); r.b = *(const h16x4*)(pr + base + hd * 64 + 32 + i4);
      r.c = *(const h16x4*)(pr + C_RTV + hd * 64 + vh * 32 + (sj & 7) * 4);
    }
  };
  auto process = [&](int tb, const Raw& r, char* buf) {
    float* sq = (float*)buf; float* sk = sq + T * 64; float* sg = sk + T * 64; float* sv = sg + T * 64;
    if (MX == 0) {
      float4 qo, ko, go; float* qp = (float*)&qo; float* kp = (float*)&ko; float* gp = (float*)&go;
#pragma unroll
      for (int i = 0; i < 4; ++i) {
        const float f = c0[i] + (1.f - c0[i]) * sigm((float)r.b[i]);
        qp[i] = silu((float)r.a[i]); kp[i] = 1.f - f; gp[i] = fmaxf(f, 1e-30f);
      }
      *(float4*)(sq + st * 64 + sj * 4) = qo; *(float4*)(sk + st * 64 + sj * 4) = ko; *(float4*)(sg + st * 64 + sj * 4) = go;
    } else if (MX == 1) {
#pragma unroll
      for (int i = 0; i < 2; ++i) {
        float z = ba[i];
#pragma unroll
        for (int rr = 0; rr < 8; ++rr) z += (float)r.g0[rr] * wa[i][rr] + (float)r.g1[rr] * wa[i][8 + rr];
        const float ls = fminf(z, 0.f) - __logf(1.f + __expf(-fabsf(z)));
        sq[st * 64 + sj * 2 + i] = (float)r.a[i] * 0.17677669529663687f;
        sk[st * 64 + sj * 2 + i] = (float)r.a[2 + i];
        sg[st * 64 + sj * 2 + i] = __expf(ls * 0.0625f);
      }
    } else {
      const int i4 = (sj & 7) * 4;
      const float* rp = p.rope + (size_t)(tb + st) * 64;
      const float4 cs = *(const float4*)(rp + i4), sn = *(const float4*)(rp + 32 + i4);
      const float* cp = (const float*)&cs; const float* sp = (const float*)&sn;
      const float sc = sj < 8 ? 1.f : 0.125f;
      float* dst = sj < 8 ? sq : sk;
      float4 o1, o2; float* p1 = (float*)&o1; float* p2 = (float*)&o2;
#pragma unroll
      for (int i = 0; i < 4; ++i) {
        const float x1 = (float)r.a[i], x2 = (float)r.b[i];
        p1[i] = (x1 * cp[i] - x2 * sp[i]) * sc; p2[i] = (x1 * sp[i] + x2 * cp[i]) * sc;
      }
      *(float4*)(dst + st * 64 + i4) = o1; *(float4*)(dst + st * 64 + 32 + i4) = o2;
    }
    if (sj < 8) *(float4*)(sv + st * 64 + sj * 4) = make_float4((float)r.c[0], (float)r.c[1], (float)r.c[2], (float)r.c[3]);
  };
  auto flush = [&](int tb, const char* buf) {
    if (sj >= 8) return;
    const float* sop = (const float*)buf + IN_F;
    float4 o = *(const float4*)(sop + (st * 8 + 0) * 32 + sj * 4);
#pragma unroll
    for (int w = 1; w < 8; ++w) { const float4 x = *(const float4*)(sop + (st * 8 + w) * 32 + sj * 4); o.x += x.x; o.y += x.y; o.z += x.z; o.w += x.w; }
    h16x4 oh = {(h16)o.x, (h16)o.y, (h16)o.z, (h16)o.w};
    *(h16x4*)(p.o + (size_t)(tok0 + tb + st) * DM + MX * 256 + hd * 64 + vh * 32 + sj * 4) = oh;
  };

  const int nbat = L / T;
  Raw raw;
  __builtin_amdgcn_s_waitcnt(0x0F70);
  load_raw(0, raw);
  for (int bt = 0; bt < nbat; ++bt) {
    char* buf = smem + (bt & 1) * BUF;
    process(bt * T, raw, buf);
    __syncthreads();
    if (bt > 0) flush((bt - 1) * T, smem + ((bt - 1) & 1) * BUF);
    if (bt + 1 < nbat) load_raw((bt + 1) * T, raw);
    {
      const float* sq = (const float*)buf; const float* sk = sq + T * 64; const float* sg = sk + T * 64; const float* sv = sg + T * 64;
      float* sop = (float*)buf + IN_F;
      constexpr int GS = 4, NC = KL / 4;
#pragma nounroll
      for (int t0 = 0; t0 < T; t0 += GS) {
        float vv[GS]; f32x4 q4[GS][NC], k4[GS][NC], g4[GS][NC];
#pragma unroll
        for (int u = 0; u < GS; ++u) {
          vv[u] = sv[(t0 + u) * 64 + v32];
#pragma unroll
          for (int j = 0; j < NC; ++j) {
            const int o_ = (t0 + u) * 64 + krow0 + j * 4;
            q4[u][j] = *(const f32x4*)(sq + o_); k4[u][j] = *(const f32x4*)(sk + o_);
            if (MX != 3) g4[u][j] = *(const f32x4*)(sg + o_); else g4[u][j] = (f32x4){gam, gam, gam, gam};
          }
        }
#pragma unroll
        for (int u = 0; u < GS; ++u) {
          f32x2 acc = {0.f, 0.f};
#pragma unroll
          for (int j = 0; j < NC; ++j) {
            S[2 * j] = g4[u][j].xy * S[2 * j] + k4[u][j].xy * vv[u];
            acc += q4[u][j].xy * S[2 * j];
            S[2 * j + 1] = g4[u][j].zw * S[2 * j + 1] + k4[u][j].zw * vv[u];
            acc += q4[u][j].zw * S[2 * j + 1];
          }
          sop[((t0 + u) * 8 + wave * 2 + kh) * 32 + v32] = acc.x + acc.y;
        }
      }
    }
  }
  __syncthreads();
  flush((nbat - 1) * T, smem + ((nbat - 1) & 1) * BUF);
  {
    float* dp;
    if (MX == 0) dp = p.out + O_PHG + ((size_t)(l * 8 + s) * 4 + hd) * 4096;
    else if (MX == 1) dp = p.out + O_PGLA + ((size_t)(l * 8 + s) * 4 + hd) * 2048;
    else dp = p.out + O_PRET + ((size_t)(l * 8 + s) * 4 + hd) * 4096;
#pragma unroll
    for (int j = 0; j < NP; ++j) { dp[(krow0 + 2 * j) * 64 + vh * 32 + v32] = S[j].x; dp[(krow0 + 2 * j + 1) * 64 + vh * 32 + v32] = S[j].y; }
  }
  __syncthreads();
}

DEV void recur_phase(const Params& p, int l, char* smem, int bid, int nb, int rep) {
  int* s_idx = (int*)(smem + 65536 + 16);
  const int total = 128 + 192 + 1024;
  for (;;) {
    if (tidx() == 0) *s_idx = (int)atomicAdd(p.ctr + l + 2 * rep, 1u);
    __syncthreads();
    const int idx = *s_idx;
    __syncthreads();
    if (idx >= total) break;
    if (idx < 128) {
      recur_item<2>(p, l, idx >> 4, (idx >> 2) & 3, idx & 3, smem);
    } else if (idx < 320) {
      const int r = idx - 128, mi = r >> 6, sq_ = (r >> 3) & 7, hd = (r >> 1) & 3, vh = r & 1;
      if (mi == 0) recur_wide<0>(p, l, sq_, hd, vh, smem);
      else if (mi == 1) recur_wide<1>(p, l, sq_, hd, vh, smem);
      else recur_wide<3>(p, l, sq_, hd, vh, smem);
    } else {
      const int r = idx - 320, mi = r >> 8, rem = r & 255, bp = rem >> 2, hd = rem & 3;
      if (mi == 0) recur_sample<2>(p, l, bp, hd, smem);
      else if (mi == 1) recur_sample<0>(p, l, bp, hd, smem);
      else if (mi == 2) recur_sample<1>(p, l, bp, hd, smem);
      else recur_sample<3>(p, l, bp, hd, smem);
    }
  }
}

DEV void post_phase(const Params& p, int l, char* smem, int bid, int nb) {
  h16* s_g16 = (h16*)smem;
  float* s_g = (float*)smem;
  const int tid = tidx(), j = tid;
  const float* mu = p.rw_mu + l * 1024;
  const float* g2 = p.rw_g2 + (size_t)l * 128 * 256;
  const float hgw = p.hg_norm_w[l * 64 + (j & 63)], glw = p.gla_norm_w[l * 64 + (j & 63)];
  const float lnw = p.rw_ln_w[l * 256 + j], lnb = p.rw_ln_b[l * 256 + j], rk = p.rw_rk[l * 256 + j], ka = p.rw_ka[l * 256 + j];
  const float mur = mu[j], muk = mu[320 + j], muv = mu[576 + j];
  for (int tile = bid; tile < M_TOK / 16; tile += nb) {
    const int tok0 = tile * 16;
    {
      const int tt = tid >> 4, c8 = (tid & 15) * 8, tok = tok0 + tt;
      int tpos, b;
      if (tok < M_PROMPT) { tpos = tok & 2047; b = -1; } else { tpos = (tok - M_PROMPT) & 7; b = (tok - M_PROMPT) >> 3; }
      const h16x8 cur = *(const h16x8*)(p.P + (size_t)tok * NPC + C_RW + 896 + c8);
      float pv[8];
      if (tpos > 0) { const h16x8 pr = *(const h16x8*)(p.P + (size_t)(tok - 1) * NPC + C_RW + 896 + c8);
#pragma unroll
        for (int i = 0; i < 8; ++i) pv[i] = (float)pr[i]; }
      else if (b >= 0) {
#pragma unroll
        for (int i = 0; i < 8; ++i) pv[i] = p.st_shift[(size_t)(l * 128 + b) * 1024 + 896 + c8 + i]; }
      else {
#pragma unroll
        for (int i = 0; i < 8; ++i) pv[i] = 0.f; }
      h16x8 sg8;
#pragma unroll
      for (int i = 0; i < 8; ++i) { const float c = (float)cur[i]; sg8[i] = (h16)sigm(c + (pv[i] - c) * mu[896 + c8 + i]); }
      *(h16x8*)(s_g16 + tt * 136 + c8) = sg8;
    }
    __syncthreads();
    float* s_ag = s_g + 16 * 128;
    {
      const int lane = tid & 63, wv = tid >> 6;
      h16x8 af[4];
#pragma unroll
      for (int ks = 0; ks < 4; ++ks) af[ks] = *(const h16x8*)(s_g16 + (lane & 15) * 136 + ks * 32 + (lane >> 4) * 8);
#pragma unroll
      for (int ct = 0; ct < 4; ++ct) {
        const h16* bp = p.lora + (size_t)((wv * 4 + ct) * 16 + (lane & 15)) * 128 + (lane >> 4) * 8;
        f32x4 c = {0.f, 0.f, 0.f, 0.f};
#pragma unroll
        for (int ks = 0; ks < 4; ++ks) c = __builtin_amdgcn_mfma_f32_16x16x32_f16(af[ks], *(const h16x8*)(bp + ks * 32), c, 0, 0, 0);
#pragma unroll
        for (int r = 0; r < 4; ++r) s_ag[((lane >> 4) * 4 + r) * 256 + (wv * 4 + ct) * 16 + (lane & 15)] = c[r];
      }
    }
    __syncthreads();
    for (int t0 = 0; t0 < 16; t0 += 8) {
      float o0[8], o1[8], o2[8], o3[8], g0[8], g1[8], g3[8], rc[8], kc[8], vc[8], rp[8], kp[8], vp[8], av[8];
#pragma unroll
      for (int u = 0; u < 8; ++u) {
        const int tok = tok0 + t0 + u;
        const h16* pr = p.P + (size_t)tok * NPC;
        const h16* op = p.o + (size_t)tok * DM;
        int tpos, b;
        if (tok < M_PROMPT) { tpos = tok & 2047; b = -1; } else { tpos = (tok - M_PROMPT) & 7; b = (tok - M_PROMPT) >> 3; }
        o0[u] = (float)op[j]; o1[u] = (float)op[256 + j]; o2[u] = (float)op[512 + j]; o3[u] = (float)op[768 + j];
        g0[u] = (float)pr[C_HGG + j]; g1[u] = (float)pr[C_GLG + j]; g3[u] = (float)pr[C_RTG + j];
        rc[u] = (float)pr[C_RW + j]; kc[u] = (float)pr[C_RW + 320 + j]; vc[u] = (float)pr[C_RW + 576 + j];
        av[u] = (float)p.RWp[(size_t)tok * 512 + 256 + j];
        const h16* pp = tpos > 0 ? pr - NPC : pr;
        rp[u] = (float)pp[C_RW + j]; kp[u] = (float)pp[C_RW + 320 + j]; vp[u] = (float)pp[C_RW + 576 + j];
        if (tpos == 0) {
          if (b >= 0) { const float* sh = p.st_shift + (size_t)(l * 128 + b) * 1024; rp[u] = sh[j]; kp[u] = sh[320 + j]; vp[u] = sh[576 + j]; }
          else { rp[u] = 0.f; kp[u] = 0.f; vp[u] = 0.f; }
        }
      }
#pragma unroll
      for (int u = 0; u < 8; ++u) {
        const int tok = tok0 + t0 + u;
        h16* op = p.o + (size_t)tok * DM;
        const float ms0 = wave_sum(o0[u] * o0[u]) * (1.f / 64.f);
        const float ms1 = wave_sum(o1[u] * o1[u]) * (1.f / 64.f);
        const float ms3 = wave_sum(o3[u] * o3[u]) * (1.f / 64.f);
        const float mean = wave_sum(o2[u]) * (1.f / 64.f);
        const float d = o2[u] - mean;
        const float var = wave_sum(d * d) * (1.f / 64.f);
        const float r = rc[u] + (rp[u] - rc[u]) * mur, km = kc[u] + (kp[u] - kc[u]) * muk, v = vc[u] + (vp[u] - vc[u]) * muv;
        const float k2 = km * (1.f + (av[u] - 1.f) * ka);
        const float bs = wave_sum(r * k2 * rk);
        op[j] = (h16)(o0[u] * rsqrtf(ms0 + 1e-6f) * hgw * silu(g0[u]));
        op[256 + j] = (h16)(o1[u] * rsqrtf(ms1 + 1e-6f) * glw * silu(g1[u]));
        op[512 + j] = (h16)((d * rsqrtf(var + 64e-5f) * lnw + lnb + bs * v) * s_ag[(t0 + u) * 256 + j]);
        op[768 + j] = (h16)(o3[u] * rsqrtf(ms3 + 1e-6f) * silu(g3[u]));
      }
    }
    __syncthreads();
  }
}

#define XB_TMO      128
#define XB_XCNT(j)  (256  + 64 * (j))
#define XB_XSUB(j)  (1280 + 64 * (j))
#define XB_XGEN(j)  (2304 + 64 * (j))
#define XB_TOP      3328
#define XB_TOPGEN   3392
#define XCD_BAR_WORDS 3456
#define XB_SPIN_CAP (1u << 20)
#define LAS __attribute__((address_space(3)))
DEV unsigned xb_ld(unsigned* p) { return __hip_atomic_load(p, __ATOMIC_RELAXED, __HIP_MEMORY_SCOPE_AGENT); }
DEV unsigned xb_add(unsigned* p, unsigned v) { return __hip_atomic_fetch_add(p, v, __ATOMIC_RELAXED, __HIP_MEMORY_SCOPE_AGENT); }
DEV unsigned xb_xcc_id() { return (unsigned)__builtin_amdgcn_s_getreg((3 << 11) | 20) & 0xFu; }
#define XB_SPIN(cond, bar) do { unsigned _sp = 0; while (cond) { __builtin_amdgcn_s_sleep(1); \
    if ((++_sp & 255u) == 0u) { if (xb_ld(&(bar)[XB_TMO])) break; if (_sp > XB_SPIN_CAP) { atomicAdd(&(bar)[XB_TMO], 1u); break; } } } } while (0)
struct XcdBarrier { unsigned* bar; unsigned x; volatile LAS unsigned* st; };
DEV XcdBarrier xcd_barrier_post(unsigned* bar, volatile LAS unsigned* st) {
  XcdBarrier b; b.bar = bar; b.x = xb_xcc_id(); b.st = st;
  if (threadIdx.x == 0) (void)xb_add(&bar[XB_XCNT(b.x)], 1u);
  return b;
}
DEV void xcd_barrier_complete(unsigned* bar, unsigned x, unsigned& nloc, unsigned& nx) {
  const unsigned G = gridDim.x * gridDim.y * gridDim.z;
  unsigned sum, cnt, mine, sp = 0u;
  for (;;) {
    sum = 0u; cnt = 0u; mine = 0u;
#pragma unroll
    for (unsigned j = 0; j < 16; ++j) { const unsigned c = xb_ld(&bar[XB_XCNT(j)]); sum += c; cnt += (c > 0u) ? 1u : 0u; mine = (j == x) ? c : mine; }
    if (sum == G) break;
    __builtin_amdgcn_s_sleep(1);
    if ((++sp & 255u) == 0u) { if (xb_ld(&bar[XB_TMO])) break; if (sp > XB_SPIN_CAP) { atomicAdd(&bar[XB_TMO], 1u); break; } }
  }
  nloc = mine > 0u ? mine : 1u; nx = cnt > 0u ? cnt : 1u;
}
DEV void xcd_barrier(const XcdBarrier& b) {
  asm volatile("s_waitcnt vmcnt(0)" ::: "memory");
  __syncthreads();
  if (threadIdx.x == 0) {
    unsigned* bar = b.bar;
    __builtin_amdgcn_s_waitcnt(0);
    unsigned nloc = b.st[0], nx = b.st[1];
    if (nloc == 0u) { xcd_barrier_complete(bar, b.x, nloc, nx); b.st[0] = nloc; b.st[1] = nx; }
    const unsigned old = xb_add(&bar[XB_XSUB(b.x)], 1u);
    const unsigned gen = old / nloc;
    if (old + 1u == (gen + 1u) * nloc) {
      __builtin_amdgcn_fence(__ATOMIC_RELEASE, "agent");
      asm volatile("s_waitcnt vmcnt(0)" ::: "memory");
      const unsigned og = xb_add(&bar[XB_TOP], 1u);
      const unsigned tg = og / nx;
      if (og + 1u == (tg + 1u) * nx) xb_add(&bar[XB_TOPGEN], 1u);
      else XB_SPIN(xb_ld(&bar[XB_TOPGEN]) == tg, bar);
      __builtin_amdgcn_fence(__ATOMIC_ACQUIRE, "agent");
      xb_add(&bar[XB_XGEN(b.x)], 1u);
      asm volatile("s_waitcnt vmcnt(0)" ::: "memory");
    } else {
      XB_SPIN(xb_ld(&bar[XB_XGEN(b.x)]) == gen, bar);
      __builtin_amdgcn_fence(__ATOMIC_ACQUIRE, "agent");
      asm volatile("s_waitcnt vmcnt(0)" ::: "memory");
    }
  }
  __syncthreads();
}

constexpr int N_PHASE = 24;
DEV void run_phase(const Params& p, int ph, char* smem, int bid, int nb) {
  if (ph == 0) { conv_phase(p, 0, smem, bid, nb); norm_phase<false>(p, 0, p.attn_norm_w, bid, nb); return; }
  if (ph == 23) { norm_phase<true>(p, 1, p.final_norm_w, bid, nb); return; }
  const int l = (ph - 1) / 11, s = (ph - 1) % 11;
  switch (s) {
    case 0: gemm1_phase(p, smem, bid, nb); break;
    case 1: prep_phase(p, l, smem, bid, nb); break;
    case 2:
#pragma nounroll
      for (int rep = 0; rep <= PROBE_RECUR; ++rep) recur_phase(p, l, smem, bid, nb, rep);
      break;
    case 3: post_phase(p, l, smem, bid, nb); break;
    case 4: gemmG_phase(p, smem, bid, nb); break;
    case 5: gemmU_phase(p, smem, bid, nb); break;
    case 6: gemm_res_phase<16>(p, l, l == 0, p.h, p.WT + WT_OUT, smem, bid, nb); break;
    case 7: norm_phase<false>(p, 1, p.ffn_norm_w + l * DM, bid, nb); break;
    case 8: gemm4_phase(p, smem, bid, nb); break;
    case 9: gemm_res_phase<44>(p, 1, false, p.P, p.WT + WT_FOUT, smem, bid, nb); break;
    default:
      if (l == 0) { conv_phase(p, 1, smem, bid, nb); norm_phase<false>(p, 1, p.attn_norm_w + DM, bid, nb); }
      break;
  }
}

constexpr int SMEM_BYTES = 65536 + 64;
extern __shared__ __attribute__((aligned(16))) char smem[];
#if !MEGA
__global__ void __launch_bounds__(256, 2) k_single(Params p, int ph) {
  run_phase(p, ph, smem, blockIdx.x, gridDim.x);
}

#else
__global__ void __launch_bounds__(256, 2) k_mega(Params p) {
  cg::grid_group grid = cg::this_grid();
  volatile LAS unsigned* st = (volatile LAS unsigned*)(smem + 65536);
  if (threadIdx.x == 0) { st[0] = 0u; st[1] = 0u; }
  __syncthreads();
  const XcdBarrier xb = xcd_barrier_post(p.bar, st);
  if (p.out == nullptr) grid.sync();
#define PH(n) run_phase(p, n, smem, blockIdx.x, gridDim.x); xcd_barrier(xb); \
  if ((n) >= 1 && (n) <= 22 && ((PROBE_DUP >> (((n) - 1) % 11)) & 1)) { \
    run_phase(p, n, smem, blockIdx.x, gridDim.x); \
    xcd_barrier(xb); }
  PH(0) PH(1) PH(2) PH(3) PH(4) PH(5) PH(6) PH(7) PH(8) PH(9) PH(10) PH(11)
  PH(12) PH(13) PH(14) PH(15) PH(16) PH(17) PH(18) PH(19) PH(20) PH(21)
  run_phase(p, 23, smem, blockIdx.x, gridDim.x);
#undef PH
}
#endif

extern "C" void kernel_launch(void* const* d_in, const int* in_sizes, int n_in, void* d_out, int out_size, void* d_ws, size_t ws_size,
                              hipStream_t stream) {
  (void)in_sizes; (void)n_in; (void)out_size;
  if (ws_size < WS_END) { fprintf(stderr, "workspace too small: %zu < %zu\n", ws_size, (size_t)WS_END); return; }
  Params p{};
  const float** f = (const float**)&p;
  for (int i = 0; i < 31; ++i) f[i] = (const float*)d_in[i];
  p.out = (float*)d_out;
  char* ws = (char*)d_ws;
  p.WT = (h16*)(ws + WS_WT); p.h = (h16*)(ws + WS_H); p.o = (h16*)(ws + WS_O); p.P = (h16*)(ws + WS_P); p.RWp = (h16*)(ws + WS_RWP);
  p.rope = (float*)(ws + WS_ROPE); p.ctr = (unsigned*)(ws + WS_CTR); p.bar = (unsigned*)(ws + WS_BAR); p.lora = (h16*)(ws + WS_LORA);
  static int grid_blocks = 0;
  if (!grid_blocks) {
    int dev = 0, cus = 0, per_cu = 0;
    (void)hipGetDevice(&dev);
    (void)hipDeviceGetAttribute(&cus, hipDeviceAttributeMultiprocessorCount, dev);
#if MEGA
    (void)hipFuncSetAttribute((const void*)k_mega, hipFuncAttributeMaxDynamicSharedMemorySize, SMEM_BYTES);
    (void)hipOccupancyMaxActiveBlocksPerMultiprocessor(&per_cu, k_mega, 256, SMEM_BYTES);
#else
    (void)hipFuncSetAttribute((const void*)k_single, hipFuncAttributeMaxDynamicSharedMemorySize, SMEM_BYTES);
    (void)hipOccupancyMaxActiveBlocksPerMultiprocessor(&per_cu, k_single, 256, SMEM_BYTES);
#endif
    if (per_cu < 1) per_cu = 1;
    if (per_cu > 2) per_cu = 2;
    grid_blocks = cus * per_cu;
  }
  (void)hipMemsetAsync(p.ctr, 0, 256 + 3456 * 4, stream);
#if MEGA
  void* args[] = {&p};
  hipError_t e = hipLaunchCooperativeKernel((void*)k_mega, dim3(grid_blocks), dim3(256), args, SMEM_BYTES, stream);
  if (e != hipSuccess) fprintf(stderr, "cooperative launch failed: %s (grid %d)\n", hipGetErrorString(e), grid_blocks);
#else
  for (int ph = 0; ph < N_PHASE; ++ph) {
    if (ph == 22) continue;
    k_single<<<grid_blocks, 256, SMEM_BYTES, stream>>>(p, ph);
  }
#endif
}
```
